# Optimizing an MI355X kernel written in HIP

```python
import math
import jax, jax.numpy as jnp
from jax import lax
import numpy as np

D_MODEL = 1024
BATCH = 32
SEQ = 2048
DEPTH = 1

HEAD_DIM = 64
N_HEADS = D_MODEL // HEAD_DIM
N_HEADS_FOX = N_HEADS // 2
N_HEADS_DIL = N_HEADS - N_HEADS_FOX
W_FOX = N_HEADS_FOX * HEAD_DIM
W_DIL = N_HEADS_DIL * HEAD_DIM
DILATION_PAIRS = ((128, 1), (512, 4), (2048, 16))
ROPE_THETA = 500000.0
ROPE_DIM = HEAD_DIM // 4
Q_BLOCK = 128
D_FF = -(-8 * D_MODEL // (3 * 256)) * 256
EPS = 1e-6
NEG = -1e30
IN_SPLITS = (W_FOX, 2 * W_FOX, 3 * W_FOX, 3 * W_FOX + N_HEADS_FOX,
             3 * W_FOX + N_HEADS_FOX + W_DIL, 3 * W_FOX + N_HEADS_FOX + 2 * W_DIL)
IN_COLS = 3 * W_FOX + N_HEADS_FOX + 3 * W_DIL

kernel_name = "hymba_fox_dilated_hybrid"


def rms_norm(x, g):
    xf = x.astype(jnp.float32)
    y = xf * lax.rsqrt(jnp.mean(xf * xf, axis=-1, keepdims=True) + EPS)
    return (y * g.astype(jnp.float32)).astype(x.dtype)


def partial_rope(x, pos):
    half = ROPE_DIM // 2
    inv_freq = jnp.power(jnp.float32(ROPE_THETA),
                         -jnp.arange(half, dtype=jnp.float32) * 2.0 / ROPE_DIM)
    ang = pos.astype(jnp.float32)[:, None] * inv_freq[None, :]
    cos = jnp.cos(ang)[None, :, None, :]
    sin = jnp.sin(ang)[None, :, None, :]
    x1 = x[..., :half]
    x2 = x[..., half:ROPE_DIM]
    return jnp.concatenate([x1 * cos - x2 * sin, x2 * cos + x1 * sin, x[..., ROPE_DIM:]], axis=-1)


def fox_attention(q, k, v, log_f):
    S = q.shape[1]
    c = jnp.transpose(jnp.cumsum(log_f, axis=1), (0, 2, 1))
    scale = HEAD_DIM ** -0.5
    outs = []
    for i in range(S // Q_BLOCK):
        q0, q1 = i * Q_BLOCK, (i + 1) * Q_BLOCK
        s = jnp.einsum('bqhe,bkhe->bhqk', q[:, q0:q1], k[:, :q1]) * scale
        s = s + (c[:, :, q0:q1, None] - c[:, :, None, :q1])
        mask = np.arange(q0, q1)[:, None] >= np.arange(q1)[None, :]
        s = jnp.where(mask[None, None], s, NEG)
        p = jax.nn.softmax(s, axis=-1)
        outs.append(jnp.einsum('bhqk,bkhe->bqhe', p, v[:, :q1]))
    return jnp.concatenate(outs, axis=1)


def dilated_branch(q, k, v, window, dilation):
    B, S, H, D = q.shape
    n = S // dilation
    wk = window // dilation
    pad = min(wk, n)
    bq = math.gcd(Q_BLOCK, n)
    nb = n // bq
    L = bq + pad
    scale = HEAD_DIM ** -0.5
    qs = q.reshape(B, nb, bq, dilation, H, D)
    kp = jnp.pad(k.reshape(B, n, dilation, H, D), ((0, 0), (pad, 0), (0, 0), (0, 0), (0, 0)))
    vp = jnp.pad(v.reshape(B, n, dilation, H, D), ((0, 0), (pad, 0), (0, 0), (0, 0), (0, 0)))
    starts = np.arange(nb) * bq
    idx = starts[:, None] + np.arange(L)[None, :]
    kb = kp[:, idx]
    vb = vp[:, idx]
    s = jnp.einsum('bnirhe,bnjrhe->bnrhij', qs, kb) * scale
    ii = np.arange(bq)[:, None]
    jj = np.arange(L)[None, :]
    dist = ii + pad - jj
    key_pos = starts[:, None, None] + jj[None] - pad
    mask = (dist >= 0)[None] & (dist <= wk)[None] & (key_pos >= 0)
    s = jnp.where(mask[None, :, None, None], s, NEG)
    lse = jax.nn.logsumexp(s, axis=-1)
    p = jnp.exp(s - lse[..., None])
    o = jnp.einsum('bnrhij,bnjrhe->bnirhe', p, vb).reshape(B, S, H, D)
    lse = jnp.transpose(lse, (0, 1, 4, 2, 3)).reshape(B, S, H)
    return o, lse


def dilated_attention(q, k, v):
    outs, lses = [], []
    for window, dilation in DILATION_PAIRS:
        o, l = dilated_branch(q, k, v, window, dilation)
        outs.append(o)
        lses.append(l)
    w = jax.nn.softmax(jnp.stack(lses, axis=0), axis=0)
    return jnp.sum(w[..., None] * jnp.stack(outs, axis=0), axis=0)


def setup_inputs(seed: int = 0) -> dict:
    key = jax.random.key(seed)
    ks = jax.random.split(key, 16)
    f32 = jnp.float32

    def gain(k, shape):
        return jnp.ones(shape, f32) + 0.02 * jax.random.normal(k, shape, f32)

    return {
        "x": jax.random.normal(ks[0], (BATCH, SEQ, D_MODEL), f32),
        "g_mix": gain(ks[1], (DEPTH, D_MODEL)),
        "w_in": jax.random.normal(ks[2], (DEPTH, D_MODEL, IN_COLS), f32) * D_MODEL ** -0.5,
        "b_forget": jax.random.uniform(ks[3], (DEPTH, N_HEADS_FOX), f32, minval=1.0, maxval=4.0),
        "g_q_fox": gain(ks[4], (DEPTH, HEAD_DIM)),
        "g_k_fox": gain(ks[5], (DEPTH, HEAD_DIM)),
        "g_q_dil": gain(ks[6], (DEPTH, HEAD_DIM)),
        "g_k_dil": gain(ks[7], (DEPTH, HEAD_DIM)),
        "g_out_fox": gain(ks[8], (DEPTH, W_FOX)),
        "g_out_dil": gain(ks[9], (DEPTH, W_DIL)),
        "w_out": jax.random.normal(ks[10], (DEPTH, D_MODEL, D_MODEL), f32) * D_MODEL ** -0.5,
        "g_ffn": gain(ks[11], (DEPTH, D_MODEL)),
        "w_gate": jax.random.normal(ks[12], (DEPTH, D_MODEL, D_FF), f32) * D_MODEL ** -0.5,
        "w_up": jax.random.normal(ks[13], (DEPTH, D_MODEL, D_FF), f32) * D_MODEL ** -0.5,
        "w_down": jax.random.normal(ks[14], (DEPTH, D_FF, D_MODEL), f32) * D_FF ** -0.5,
    }


def reference(x, g_mix, w_in, b_forget, g_q_fox, g_k_fox, g_q_dil, g_k_dil,
              g_out_fox, g_out_dil, w_out, g_ffn, w_gate, w_up, w_down):
    B, S, _ = x.shape
    f32 = jnp.float32
    pos = jnp.arange(S)

    def heads(t, n_h):
        return t.reshape(B, S, n_h, HEAD_DIM).astype(f32)

    for l in range(DEPTH):
        h = rms_norm(x, g_mix[l])
        proj = jnp.einsum('bsd,dc->bsc', h, w_in[l])
        qa, ka, va, fa, qd, kd, vd = jnp.split(proj, IN_SPLITS, axis=-1)

        qa = rms_norm(heads(qa, N_HEADS_FOX), g_q_fox[l])
        ka = rms_norm(heads(ka, N_HEADS_FOX), g_k_fox[l])
        va = heads(va, N_HEADS_FOX)
        log_f = jax.nn.log_sigmoid(fa.astype(f32) + b_forget[l].astype(f32))
        o_fox = fox_attention(qa, ka, va, log_f).reshape(B, S, W_FOX)

        qd = partial_rope(rms_norm(heads(qd, N_HEADS_DIL), g_q_dil[l]), pos)
        kd = partial_rope(rms_norm(heads(kd, N_HEADS_DIL), g_k_dil[l]), pos)
        vd = heads(vd, N_HEADS_DIL)
        o_dil = dilated_attention(qd, kd, vd).reshape(B, S, W_DIL)

        o = jnp.concatenate([rms_norm(o_fox, g_out_fox[l]), rms_norm(o_dil, g_out_dil[l])], axis=-1)
        x = x + jnp.einsum('bsc,cd->bsd', o.astype(x.dtype), w_out[l])

        h = rms_norm(x, g_ffn[l])
        a = jnp.einsum('bsd,df->bsf', h, w_gate[l])
        u = jnp.einsum('bsd,df->bsf', h, w_up[l])
        x = x + jnp.einsum('bsf,fd->bsd', jax.nn.silu(a) * u, w_down[l])
    return x
```

```cpp
#include <hip/hip_runtime.h>
#include <hip/hip_cooperative_groups.h>
#include <cstdio>
#include <cstdint>
namespace cg = cooperative_groups;
namespace pg8 {
#define PG8_LAS __attribute__((address_space(3)))
typedef unsigned short bf16_t;
typedef short bf16x8 __attribute__((ext_vector_type(8)));
typedef float f32x4 __attribute__((ext_vector_type(4)));
typedef unsigned u32x4 __attribute__((ext_vector_type(4)));
constexpr int BM = 256, BK = 64, HALF = 128, HTB = HALF * BK * 2  , STAGE_BYTES = 8 * HTB, NXCD = 8, WGM = 8;

__host__ __device__ __forceinline__ int lds_byte(int r, int c) { const int st = (r >> 4) * 2 + (c >> 5), rr = r & 15, cc = c & 31, ob = rr * 64 + cc * 2; return st * 1024 + (ob ^ (((ob >> 9) & 1) << 5)); }
__host__ __device__ __forceinline__ void stage_rc(int b, int& R, int& C) { const int st = b / 1024, sb = b % 1024, swz = sb ^ (((sb >> 9) & 1) << 5); R = (st >> 1) * 16 + swz / 64; C = (st & 1) * 32 + (swz % 64) / 2; }
__host__ __device__ __forceinline__ int perm32(int rho) { const int n = rho >> 4, i = rho & 15; return 8 * (i >> 2) + 4 * n + (i & 3); }

struct Unit { int pm, pn; };
struct Gemm { const bf16_t* A; const bf16_t* Bt; int M, N, K; };

struct StaticOrder {
    int nM, nN, nwg, G, c;
    __host__ __device__ void init(int M, int N, int G_, int c_) { nM = M / BM; nN = N / BM; nwg = nM * nN; G = G_; c = c_; }
    __host__ __device__ bool next(int i, Unit& u) const {
        const long L = (long)i * G + c; if (L >= nwg) return false;
        int wgid = (int)L; { const int q = nwg / NXCD, r = nwg % NXCD, xcd = wgid % NXCD, off = wgid / NXCD; wgid = (xcd < r ? xcd * (q + 1) : r * (q + 1) + (xcd - r) * q) + off; }
        const int nig = WGM * nN, gid = wgid / nig, fm = gid * WGM, gsz = (nM - fm) < WGM ? (nM - fm) : WGM;
        u.pm = fm + ((wgid % nig) % gsz); u.pn = (wgid % nig) / gsz; return true;
    }
    __device__ __forceinline__ void a_ready(const Unit&) const {}
    __device__ __forceinline__ void done(const Unit&) const {}
};

__device__ __forceinline__ unsigned cvt_pk_bf16(float lo, float hi) { unsigned r; asm volatile("v_cvt_pk_bf16_f32 %0, %1, %2" : "=v"(r) : "v"(lo), "v"(hi)); return r; }
template <class Epi, class Sched, bool ALIGN_EPI = false, bool SP2 = false>
__device__ __forceinline__ void gemm_phase(PG8_LAS unsigned char* lds, const Gemm g, const Sched& S, const Epi& E) {
    const int tid = threadIdx.x, wid = __builtin_amdgcn_readfirstlane(tid >> 6), lane = tid & 63, wr = wid >> 2, wc = wid & 3, fr = lane & 15, fq = lane >> 4;
    const int K = g.K, nt = K / BK;
    unsigned voffA[2], voffB[2];
#pragma unroll
    for (int i = 0; i < 2; ++i) { int R, C; stage_rc(tid * 16 + i * 8192, R, C); const int Rb = Epi::PERM ? ((R & ~31) + perm32(R & 31)) : R;
        voffA[i] = (unsigned)(R * K + C) * 2u; voffB[i] = (unsigned)(Rb * K + C) * 2u; }
    const size_t kstep = (size_t)(BK * 2);
    const size_t hstep = (size_t)HALF * K * 2;
    const size_t tstep = 2 * hstep;
    const unsigned ldsw = (unsigned)wid * 1024u;
    const int aoff = lds_byte(wr * 64 + fr, fq * 8), boff = lds_byte(wc * 32 + fr, fq * 8);
#define PG8_SA(b, h) (((b) * 2 + (h)) * HTB)
#define PG8_SB(b, h) ((4 + (b) * 2 + (h)) * HTB)
#define PG8_STAGE(bufoff, gbase, voff) do { _Pragma("unroll") for (int _i = 0; _i < 2; ++_i) \
        __builtin_amdgcn_global_load_lds((const unsigned*)((const char*)(gbase) + (voff)[_i]), (PG8_LAS unsigned*)(lds + (bufoff) + ldsw + _i * 8192), 16, 0, 0); } while (0)
#define PG8_LDA(dst, b, h) do { _Pragma("unroll") for (int m = 0; m < 4; ++m) _Pragma("unroll") for (int k = 0; k < 2; ++k) dst[m][k] = *(const PG8_LAS bf16x8*)(lds + PG8_SA(b, h) + aoff + m * 2048 + k * 1024); } while (0)
#define PG8_LDB(dst, b, h) do { _Pragma("unroll") for (int n = 0; n < 2; ++n) _Pragma("unroll") for (int k = 0; k < 2; ++k) dst[n][k] = *(const PG8_LAS bf16x8*)(lds + PG8_SB(b, h) + boff + n * 2048 + k * 1024); } while (0)
#define PG8_MMA(ai, bj, At, Bt) do { __builtin_amdgcn_s_setprio(1); _Pragma("unroll") for (int m = 0; m < 4; ++m) _Pragma("unroll") for (int n = 0; n < 2; ++n) _Pragma("unroll") for (int k = 0; k < 2; ++k) \
        acc[ai][bj][m][n] = __builtin_amdgcn_mfma_f32_16x16x32_bf16(Bt[n][k], At[m][k], acc[ai][bj][m][n], 0, 0, 0); __builtin_amdgcn_s_setprio(0); } while (0)
#define PG8_WAIT_V(n) asm volatile("s_waitcnt vmcnt(" #n ")" ::: "memory")
#define PG8_WAIT_L(n) asm volatile("s_waitcnt lgkmcnt(" #n ")" ::: "memory")
#define PG8_BAR __builtin_amdgcn_s_barrier()
#define PG8_SCHED __builtin_amdgcn_sched_barrier(0)
    Unit cur, nxt; int ui = 0;
    if (!S.next(0, cur)) return;
    f32x4 acc[2][2][4][2];
#pragma unroll
    for (int a = 0; a < 2; ++a)
#pragma unroll
        for (int b = 0; b < 2; ++b)
#pragma unroll
            for (int m = 0; m < 4; ++m)
#pragma unroll
                for (int n = 0; n < 2; ++n) acc[a][b][m][n] = (f32x4){0.f, 0.f, 0.f, 0.f};
    bf16x8 At[4][2], B0[2][2], B1[2][2];
    const char* cA = (const char*)g.A + (size_t)cur.pm * tstep; const char* cB = (const char*)g.Bt + (size_t)cur.pn * tstep;
    S.a_ready(cur);
    if constexpr (SP2) {
        PG8_STAGE(PG8_SB(0, 0), cB, voffB); PG8_STAGE(PG8_SB(0, 1), cB + hstep, voffB); PG8_STAGE(PG8_SA(0, 0), cA, voffA); PG8_STAGE(PG8_SA(0, 1), cA + hstep, voffA);
        if (wr == 1) PG8_BAR;
        PG8_WAIT_V(2); PG8_BAR;
        PG8_STAGE(PG8_SB(1, 0), cB + kstep, voffB); PG8_STAGE(PG8_SA(1, 0), cA + kstep, voffA); PG8_STAGE(PG8_SB(1, 1), cB + hstep + kstep, voffB);
        PG8_WAIT_V(6); PG8_BAR;
    } else {
        PG8_STAGE(PG8_SB(0, 0), cB, voffB); PG8_STAGE(PG8_SA(0, 0), cA, voffA); PG8_STAGE(PG8_SB(0, 1), cB + hstep, voffB); PG8_STAGE(PG8_SA(0, 1), cA + hstep, voffA);
        if (wr == 1) PG8_BAR;
        PG8_WAIT_V(4); PG8_BAR;
        PG8_STAGE(PG8_SB(1, 0), cB + kstep, voffB); PG8_STAGE(PG8_SA(1, 0), cA + kstep, voffA); PG8_STAGE(PG8_SB(1, 1), cB + hstep + kstep, voffB);
        PG8_WAIT_V(6); PG8_BAR;
    }
    for (;;) {
        const bool has_next = S.next(ui + 1, nxt);
        const char* nA = has_next ? (const char*)g.A + (size_t)nxt.pm * tstep : cA; const char* nB = has_next ? (const char*)g.Bt + (size_t)nxt.pn * tstep : cB;
        for (int t = 0; t < nt; t += 2) {
            const bool last = (t == nt - 2);
            const char* a1 = cA + (size_t)(t + 1) * kstep;
            const char* a2 = last ? nA : cA + (size_t)(t + 2) * kstep; const char* b2 = last ? nB : cB + (size_t)(t + 2) * kstep;
            const char* a3 = a2 + kstep; const char* b3 = b2 + kstep;
            if (last && has_next) S.a_ready(nxt);
            if constexpr (SP2) {
            PG8_LDB(B0, 0, 0); PG8_LDB(B1, 0, 1); PG8_SCHED; PG8_LDA(At, 0, 0); PG8_STAGE(PG8_SA(1, 1), a1 + hstep, voffA);
            PG8_WAIT_V(8); PG8_WAIT_L(0); PG8_BAR; PG8_MMA(0, 0, At, B0); PG8_MMA(0, 1, At, B1); PG8_BAR; PG8_SCHED;
            PG8_LDA(At, 0, 1); PG8_STAGE(PG8_SB(0, 0), b2, voffB); PG8_STAGE(PG8_SB(0, 1), b2 + hstep, voffB); PG8_STAGE(PG8_SA(0, 0), a2, voffA);
            PG8_WAIT_V(8); PG8_WAIT_L(0); PG8_BAR; PG8_MMA(1, 0, At, B0); PG8_MMA(1, 1, At, B1); PG8_BAR; PG8_SCHED;
            PG8_LDB(B0, 1, 0); PG8_LDB(B1, 1, 1); PG8_SCHED; PG8_LDA(At, 1, 0); PG8_STAGE(PG8_SA(0, 1), a2 + hstep, voffA);
            PG8_WAIT_V(8); PG8_WAIT_L(0); PG8_BAR; PG8_MMA(0, 0, At, B0); PG8_MMA(0, 1, At, B1); PG8_BAR; PG8_SCHED;
            PG8_LDA(At, 1, 1); PG8_STAGE(PG8_SB(1, 0), b3, voffB); PG8_STAGE(PG8_SB(1, 1), b3 + hstep, voffB); PG8_STAGE(PG8_SA(1, 0), a3, voffA);
            PG8_WAIT_V(8); PG8_WAIT_L(0); PG8_BAR; PG8_MMA(1, 0, At, B0); PG8_MMA(1, 1, At, B1); PG8_BAR; PG8_SCHED;
            } else {
            PG8_LDB(B0, 0, 0); PG8_SCHED; PG8_LDA(At, 0, 0); PG8_STAGE(PG8_SA(1, 1), a1 + hstep, voffA);
            PG8_WAIT_L(8); PG8_BAR; PG8_WAIT_L(0); PG8_MMA(0, 0, At, B0); PG8_BAR; PG8_SCHED;
            PG8_LDB(B1, 0, 1); PG8_STAGE(PG8_SB(0, 0), b2, voffB);
            PG8_BAR; PG8_WAIT_L(0); PG8_MMA(0, 1, At, B1); PG8_BAR;
            PG8_LDA(At, 0, 1); PG8_STAGE(PG8_SA(0, 0), a2, voffA);
            PG8_BAR; PG8_WAIT_L(0); PG8_MMA(1, 0, At, B0); PG8_BAR; PG8_SCHED;
            PG8_STAGE(PG8_SB(0, 1), b2 + hstep, voffB);
            PG8_WAIT_V(6); PG8_BAR; PG8_MMA(1, 1, At, B1); PG8_BAR;
            PG8_LDB(B0, 1, 0); PG8_SCHED; PG8_LDA(At, 1, 0); PG8_STAGE(PG8_SA(0, 1), a2 + hstep, voffA);
            PG8_WAIT_L(8); PG8_BAR; PG8_WAIT_L(0); PG8_MMA(0, 0, At, B0); PG8_BAR; PG8_SCHED;
            PG8_LDB(B1, 1, 1); PG8_STAGE(PG8_SB(1, 0), b3, voffB);
            PG8_BAR; PG8_WAIT_L(0); PG8_MMA(0, 1, At, B1); PG8_BAR;
            PG8_LDA(At, 1, 1); PG8_STAGE(PG8_SA(1, 0), a3, voffA);
            PG8_BAR; PG8_WAIT_L(0); PG8_MMA(1, 0, At, B0); PG8_BAR; PG8_SCHED;
            PG8_STAGE(PG8_SB(1, 1), b3 + hstep, voffB);
            PG8_WAIT_V(6); PG8_BAR; PG8_MMA(1, 1, At, B1); PG8_BAR;
            }
        }
        if constexpr (ALIGN_EPI) { if (wr == 0) PG8_BAR; }
        if constexpr (!Epi::AFTER_DRAIN) { E(acc, cur, wr, wc, fr, fq); S.done(cur); }
        if (!has_next) break;
#pragma unroll
        for (int a = 0; a < 2; ++a)
#pragma unroll
            for (int b = 0; b < 2; ++b)
#pragma unroll
                for (int m = 0; m < 4; ++m)
#pragma unroll
                    for (int n = 0; n < 2; ++n) acc[a][b][m][n] = (f32x4){0.f, 0.f, 0.f, 0.f};
        cur = nxt; cA = nA; cB = nB; ++ui;
        if constexpr (ALIGN_EPI) { if (wr == 1) PG8_BAR; }
    }
    PG8_WAIT_V(0);
    if constexpr (!ALIGN_EPI) { if (wr == 0) PG8_BAR; }
    PG8_BAR;
    if constexpr (Epi::AFTER_DRAIN) { E.fused(acc, cur, wr, wc, fr, fq, lds, wid, lane); S.done(cur); }
#undef PG8_SA
#undef PG8_SB
#undef PG8_STAGE
#undef PG8_LDA
#undef PG8_LDB
#undef PG8_MMA
#undef PG8_WAIT_V
#undef PG8_WAIT_L
#undef PG8_BAR
#undef PG8_SCHED
}
}

constexpr int BATCH = 32, SEQ = 2048, DM = 1024, MTOK = BATCH * SEQ, NQKV = 3072, FF = 2816, NGU = 2 * FF, INC = 3080;
constexpr float EPS = 1e-6f, LOG2E = 1.4426950408889634f, QSCALE = 0.125f * LOG2E;
constexpr int NTHREADS = 512, NWAVES = 8;
constexpr int LDS_BYTES = 131072 + 256 + 4096 + 256;
constexpr size_t MiB = 1u << 20;
constexpr size_t WS_GTAB = 25 * MiB + 512 * 1024, WS_CTL = 25 * MiB + 768 * 1024, CTL_BYTES = 16384;
constexpr size_t WS_WQKV = 0, WS_WO = 6 * MiB, WS_WGU = 8 * MiB, WS_WD = 19 * MiB, WS_ROPE = 25 * MiB, WS_LOGF = 26 * MiB, WS_C2 = 28 * MiB, WS_SSQ = 30 * MiB, WS_LSE = 34 * MiB;
constexpr size_t WS_QKV = 40 * MiB, WS_XN = 432 * MiB, WS_OF = 560 * MiB, WS_OD = 624 * MiB, WS_ON = WS_XN, WS_X1B = WS_QKV, WS_H = 168 * MiB, WS_END = 816 * MiB;
constexpr size_t OD_STRIDE = (size_t)MTOK * 512;
constexpr size_t HSTRIDE = (size_t)SEQ * 64 + 2048, SECS = (size_t)256 * HSTRIDE;

#define LAS __attribute__((address_space(3)))
typedef pg8::bf16_t bf16_t;
typedef pg8::f32x4 f32x4;
typedef pg8::u32x4 u32x4;
typedef unsigned u32x2 __attribute__((ext_vector_type(2)));
using pg8::cvt_pk_bf16;
__device__ __forceinline__ float bf2f(unsigned short v) { return __uint_as_float((unsigned)v << 16); }
__device__ __forceinline__ float wave_sum(float v) {
#pragma unroll
    for (int o = 1; o < 64; o <<= 1) v += __shfl_xor(v, o);
    return v;
}

__device__ __forceinline__ float xsum16(float x) { auto r = __builtin_amdgcn_permlane16_swap(__float_as_uint(x), __float_as_uint(x), false, false); return __uint_as_float(r[0]) + __uint_as_float(r[1]); }
__device__ __forceinline__ float xsum32(float x) { auto r = __builtin_amdgcn_permlane32_swap(__float_as_uint(x), __float_as_uint(x), false, false); return __uint_as_float(r[0]) + __uint_as_float(r[1]); }

struct Args {
    const float* x; const float* g_mix; const float* w_in; const float* b_forget; const float* g_q_fox; const float* g_k_fox; const float* g_q_dil; const float* g_k_dil;
    const float* g_out_fox; const float* g_out_dil; const float* w_out; const float* g_ffn; const float* w_gate; const float* w_up; const float* w_down;
    float* out; unsigned char* ws; int ph_lo, ph_hi;
};

struct EpiQKV {
    static constexpr bool PERM = true, AFTER_DRAIN = false;
    bf16_t* O; const float* gtab; const float* rope;
    __device__ __forceinline__ void operator()(const f32x4 (&acc)[2][2][4][2], const pg8::Unit& u, int wr, int wc, int fr, int fq) const {
        const int sec = u.pn >> 1;
        const bool isv = (sec == 2) || (sec == 5), isq = (sec == 0) || (sec == 3), dil = sec >= 3;
        const float* g = gtab + sec * 64;
        const size_t hbase = ((size_t)sec * 256 + (u.pn & 1) * 4 + wc) * HSTRIDE + fq * 8;
        const float qs = isq ? QSCALE : 1.f;
        f32x4 gv[2][2];
#pragma unroll
        for (int bj = 0; bj < 2; ++bj)
#pragma unroll
            for (int n = 0; n < 2; ++n) gv[bj][n] = *(const f32x4*)(g + bj * 32 + fq * 8 + n * 4) * qs;
        const bool rotu = dil && !isv;
        const bool rot = rotu && fq < 2;
        const float sgn = (fq == 0) ? -1.f : 1.f;
#pragma unroll
        for (int ai = 0; ai < 2; ++ai) {
            f32x4 cs[4][2][2];
            if (rot) {
#pragma unroll
                for (int m = 0; m < 4; ++m) { const float* rp = rope + (size_t)((u.pm * 256 + ai * 128 + wr * 64 + m * 16 + fr) & (SEQ - 1)) * 16;
#pragma unroll
                    for (int n = 0; n < 2; ++n) { cs[m][n][0] = *(const f32x4*)(rp + n * 8); cs[m][n][1] = *(const f32x4*)(rp + n * 8 + 4); } }
            }
#pragma unroll
            for (int m = 0; m < 4; ++m) {
                const int row = u.pm * 256 + ai * 128 + wr * 64 + m * 16 + fr;
                f32x4 v[2][2];
#pragma unroll
                for (int bj = 0; bj < 2; ++bj)
#pragma unroll
                    for (int n = 0; n < 2; ++n) v[bj][n] = acc[ai][bj][m][n];
                if (!isv) {
                    float ss = 0.f;
#pragma unroll
                    for (int bj = 0; bj < 2; ++bj)
#pragma unroll
                        for (int n = 0; n < 2; ++n) ss += (v[bj][n][0] * v[bj][n][0] + v[bj][n][1] * v[bj][n][1]) + (v[bj][n][2] * v[bj][n][2] + v[bj][n][3] * v[bj][n][3]);
                    ss = xsum32(xsum16(ss));
                    const float rs = __builtin_amdgcn_rsqf(ss * (1.f / 64.f) + EPS);
#pragma unroll
                    for (int bj = 0; bj < 2; ++bj)
#pragma unroll
                        for (int n = 0; n < 2; ++n) v[bj][n] = v[bj][n] * rs * gv[bj][n];
                    if (rotu) {
#pragma unroll
                        for (int n = 0; n < 2; ++n) {
                            f32x4 pr;
#pragma unroll
                            for (int e = 0; e < 4; ++e) { auto r = __builtin_amdgcn_permlane16_swap(__float_as_uint(v[0][n][e]), __float_as_uint(v[0][n][e]), false, false);
                                pr[e] = __uint_as_float((fq & 1) ? r[0] : r[1]); }
                            if (rot) {
                                const f32x4 cs0 = cs[m][n][0], cs1 = cs[m][n][1];
                                const f32x4 x = v[0][n];
                                v[0][n] = (f32x4){x[0] * cs0[0] + sgn * pr[0] * cs0[1], x[1] * cs0[2] + sgn * pr[1] * cs0[3], x[2] * cs1[0] + sgn * pr[2] * cs1[1], x[3] * cs1[2] + sgn * pr[3] * cs1[3]};
                            }
                        }
                    }
                }
                bf16_t* rowp = O + hbase + (size_t)(row >> 11) * 8 * HSTRIDE + (size_t)(row & (SEQ - 1)) * 64;
#pragma unroll
                for (int bj = 0; bj < 2; ++bj) {
                    u32x4 w; w.x = cvt_pk_bf16(v[bj][0][0], v[bj][0][1]); w.y = cvt_pk_bf16(v[bj][0][2], v[bj][0][3]); w.z = cvt_pk_bf16(v[bj][1][0], v[bj][1][1]); w.w = cvt_pk_bf16(v[bj][1][2], v[bj][1][3]);
                    *(u32x4*)(rowp + bj * 32) = w;
                }
            }
        }
    }
};
struct EpiOut {
    static constexpr bool PERM = false, AFTER_DRAIN = false;
    const float* x; bf16_t* x1b; float* ssq;
    __device__ __forceinline__ void operator()(const f32x4 (&acc)[2][2][4][2], const pg8::Unit& u, int wr, int wc, int fr, int fq) const {
        const int col0 = u.pn * 256 + wc * 32 + 4 * fq;
#pragma unroll
        for (int ai = 0; ai < 2; ++ai) {
            f32x4 xr[4][2][2];
#pragma unroll
            for (int m = 0; m < 4; ++m)
#pragma unroll
                for (int bj = 0; bj < 2; ++bj)
#pragma unroll
                    for (int n = 0; n < 2; ++n) xr[m][bj][n] = *(const f32x4*)(x + (size_t)(u.pm * 256 + ai * 128 + wr * 64 + m * 16 + fr) * DM + col0 + bj * 128 + n * 16);
            __builtin_amdgcn_sched_barrier(0);
#pragma unroll
            for (int m = 0; m < 4; ++m) {
                const int row = u.pm * 256 + ai * 128 + wr * 64 + m * 16 + fr;
                float ss = 0.f;
#pragma unroll
                for (int bj = 0; bj < 2; ++bj)
#pragma unroll
                    for (int n = 0; n < 2; ++n) {
                        const size_t off = (size_t)row * DM + col0 + bj * 128 + n * 16;
                        const f32x4 o = xr[m][bj][n] + acc[ai][bj][m][n];
                        ss += (o[0] * o[0] + o[1] * o[1]) + (o[2] * o[2] + o[3] * o[3]);
                        u32x2 w; w.x = cvt_pk_bf16(o[0], o[1]); w.y = cvt_pk_bf16(o[2], o[3]);
                        *(u32x2*)(x1b + off) = w;
                    }
                ss = xsum32(xsum16(ss));
                if (fq == 0) ssq[(size_t)(u.pn * 4 + wc) * MTOK + row] = ss;
            }
        }
    }
};
struct EpiGU {
    static constexpr bool PERM = true, AFTER_DRAIN = false;
    bf16_t* H; const float* ssq; LAS float* rtab; mutable int last_pm;
    __device__ __forceinline__ void operator()(const f32x4 (&acc)[2][2][4][2], const pg8::Unit& u, int wr, int wc, int fr, int fq) const {
        const int col0 = u.pn * 128 + wc * 32 + 8 * fq;
        LAS float* rt = rtab + wc * 256 + wr * 64 + fr;
        if (u.pm != last_pm) {
            last_pm = u.pm;
            float pp[2][4];
#pragma unroll
            for (int ai = 0; ai < 2; ++ai)
#pragma unroll
                for (int m = 0; m < 4; ++m) { const int row = u.pm * 256 + ai * 128 + wr * 64 + m * 16 + fr; float p = 0.f;
#pragma unroll
                    for (int j = 0; j < 4; ++j) p += ssq[(size_t)(fq * 4 + j) * MTOK + row];
                    pp[ai][m] = p; }
#pragma unroll
            for (int ai = 0; ai < 2; ++ai)
#pragma unroll
                for (int m = 0; m < 4; ++m) { const float p = xsum32(xsum16(pp[ai][m])); if (fq == 0) rt[ai * 128 + m * 16] = __builtin_amdgcn_rsqf(p * (1.f / DM) + EPS); }
        }
#pragma unroll
        for (int ai = 0; ai < 2; ++ai)
#pragma unroll
            for (int m = 0; m < 4; ++m) {
                const int row = u.pm * 256 + ai * 128 + wr * 64 + m * 16 + fr;
                const float rs = rt[ai * 128 + m * 16];
                typedef float f32x2 __attribute__((ext_vector_type(2)));
                const float kneg = -rs * LOG2E, rs2 = rs * rs;
                float hv[8];
#pragma unroll
                for (int n = 0; n < 2; ++n)
#pragma unroll
                    for (int e2 = 0; e2 < 2; ++e2) {
                        const f32x2 gg = {acc[ai][0][m][n][2 * e2], acc[ai][0][m][n][2 * e2 + 1]}, uu = {acc[ai][1][m][n][2 * e2], acc[ai][1][m][n][2 * e2 + 1]};
                        const f32x2 t = gg * kneg, pq = (gg * uu) * rs2;
                        f32x2 d; d.x = __builtin_amdgcn_exp2f(t.x); d.y = __builtin_amdgcn_exp2f(t.y);
                        d = d + 1.0f;
                        f32x2 r; r.x = __builtin_amdgcn_rcpf(d.x); r.y = __builtin_amdgcn_rcpf(d.y);
                        const f32x2 o = pq * r;
                        hv[n * 4 + 2 * e2] = o.x; hv[n * 4 + 2 * e2 + 1] = o.y;
                    }
                u32x4 w; w.x = cvt_pk_bf16(hv[0], hv[1]); w.y = cvt_pk_bf16(hv[2], hv[3]); w.z = cvt_pk_bf16(hv[4], hv[5]); w.w = cvt_pk_bf16(hv[6], hv[7]);
                *(u32x4*)(H + (size_t)row * FF + col0) = w;
            }
    }
};
struct EpiDown {
    static constexpr bool PERM = false, AFTER_DRAIN = false;
    float* out; const bf16_t* x1b;
    __device__ __forceinline__ void operator()(const f32x4 (&acc)[2][2][4][2], const pg8::Unit& u, int wr, int wc, int fr, int fq) const {
        const int col0 = u.pn * 256 + wc * 32 + 4 * fq;
        u32x2 xw[2][4][2][2];
#pragma unroll
        for (int ai = 0; ai < 2; ++ai)
#pragma unroll
            for (int m = 0; m < 4; ++m)
#pragma unroll
                for (int bj = 0; bj < 2; ++bj)
#pragma unroll
                    for (int n = 0; n < 2; ++n) xw[ai][m][bj][n] = *(const u32x2*)(x1b + (size_t)(u.pm * 256 + ai * 128 + wr * 64 + m * 16 + fr) * DM + col0 + bj * 128 + n * 16);
        __builtin_amdgcn_sched_barrier(0);
#pragma unroll
        for (int ai = 0; ai < 2; ++ai)
#pragma unroll
            for (int m = 0; m < 4; ++m) {
                const int row = u.pm * 256 + ai * 128 + wr * 64 + m * 16 + fr;
#pragma unroll
                for (int bj = 0; bj < 2; ++bj)
#pragma unroll
                    for (int n = 0; n < 2; ++n) {
                        const size_t off = (size_t)row * DM + col0 + bj * 128 + n * 16;
                        const u32x2 w = xw[ai][m][bj][n];
                        const f32x4 xr = {__uint_as_float(w.x << 16), __uint_as_float(w.x & 0xffff0000u), __uint_as_float(w.y << 16), __uint_as_float(w.y & 0xffff0000u)};
                        *(f32x4*)(out + off) = xr + acc[ai][bj][m][n];
                    }
            }
    }
};
template <int WHICH> __device__ __forceinline__ void tr_item(const float* W, const float* W2, const float* gk, bf16_t* WT, int K, int Nsrc, int Nd, LAS float* scr, int item, int lane) {
    const int nblk = Nd / 32, kb = item / nblk, nb = item % nblk, k0 = 64 * kb, c0 = 32 * nb;
    const int c = c0 + (lane & 31);
    int sc; const float* src = W;
    if (WHICH == 0) { const int pn = c >> 8, cp = c & 255; const int bc = pn * 256 + ((cp >> 5) & 3) * 64 + (cp >> 7) * 32 + ((cp >> 3) & 3) * 8 + (cp & 7); sc = bc < 1536 ? bc : bc + 8; }
    else if (WHICH == 2) { const int pn = c >> 8, cp = c & 255; sc = pn * 128 + (cp & 127); src = (cp >> 7) ? W2 : W; }
    else sc = c;
#pragma unroll 8
    for (int i = 0; i < 32; ++i) { const int kk = 2 * i + (lane >> 5); float v = __builtin_nontemporal_load(src + (size_t)(k0 + kk) * Nsrc + sc); if (gk) v *= gk[k0 + kk]; scr[kk * 33 + (lane & 31)] = v; }
    asm volatile("s_waitcnt lgkmcnt(0)" ::: "memory");
    const int c8 = lane & 7;
#pragma unroll
    for (int j = 0; j < 4; ++j) { const int n = (lane >> 3) + 8 * j; const LAS float* s = scr + (8 * c8) * 33 + n;
        u32x4 o; o.x = cvt_pk_bf16(s[0 * 33], s[1 * 33]); o.y = cvt_pk_bf16(s[2 * 33], s[3 * 33]); o.z = cvt_pk_bf16(s[4 * 33], s[5 * 33]); o.w = cvt_pk_bf16(s[6 * 33], s[7 * 33]);
        *(u32x4*)(WT + (size_t)(c0 + n) * K + k0 + 8 * c8) = o; }
    asm volatile("s_waitcnt lgkmcnt(0)" ::: "memory");
}
__device__ __forceinline__ void p0_prologue(const Args& A, LAS unsigned char* lds, int vcu, int G, int wave, int lane) {
    unsigned char* ws = A.ws;
    LAS float* scr = (LAS float*)(lds + wave * 16384);
    const int gw = vcu * NWAVES + wave, NGW = G * NWAVES;
    constexpr int I_QKV = (DM / 64) * (NQKV / 32), I_O = (DM / 64) * (DM / 32), I_GU = (DM / 64) * (NGU / 32), I_D = (FF / 64) * (DM / 32), NITEMS = I_QKV + I_O + I_GU + I_D;
    for (int it = gw; it < NITEMS; it += NGW) {
        int r = it;
        if (r < I_QKV) { tr_item<0>(A.w_in, nullptr, nullptr, (bf16_t*)(ws + WS_WQKV), DM, INC, NQKV, scr, r, lane); continue; } r -= I_QKV;
        if (r < I_O) { tr_item<1>(A.w_out, nullptr, nullptr, (bf16_t*)(ws + WS_WO), DM, DM, DM, scr, r, lane); continue; } r -= I_O;
        if (r < I_GU) { tr_item<2>(A.w_gate, A.w_up, A.g_ffn, (bf16_t*)(ws + WS_WGU), DM, FF, NGU, scr, r, lane); continue; } r -= I_GU;
        tr_item<1>(A.w_down, nullptr, nullptr, (bf16_t*)(ws + WS_WD), FF, DM, DM, scr, r, lane);
    }
    {
        const float invf[8] = {1.0f, 0.1939227432012558f, 0.03760603070259094f, 0.007292664609849453f, 0.0014142135623842478f, 0.00027424818836152554f, 5.318296098266728e-05f, 1.0313386155758053e-05f};
        float* rope = (float*)(ws + WS_ROPE);
        for (int idx = gw * 64 + lane; idx < SEQ * 8; idx += NGW * 64) {
            const int pos = idx >> 3, i = idx & 7;
            float fr_ = invf[0];
#pragma unroll
            for (int j = 1; j < 8; ++j) fr_ = (i == j) ? invf[j] : fr_;
            const float angf = (float)pos * fr_;
            const double a = (double)angf, kq = rint(a * 0.63661977236758134308);
            double r = fma(-kq, 1.5707963267948966, a); r = fma(-kq, 6.123233995736766e-17, r);
            const int q = (int)((long long)kq & 3);
            const double r2 = r * r;
            const double sr = r * (1.0 + r2 * (-1.0 / 6 + r2 * (1.0 / 120 + r2 * (-1.0 / 5040 + r2 * (1.0 / 362880 + r2 * (-1.0 / 39916800 + r2 * (1.0 / 6227020800.0)))))));
            const double cr = 1.0 + r2 * (-0.5 + r2 * (1.0 / 24 + r2 * (-1.0 / 720 + r2 * (1.0 / 40320 + r2 * (-1.0 / 3628800 + r2 * (1.0 / 479001600.0))))));
            const double s = (q == 0) ? sr : (q == 1) ? cr : (q == 2) ? -sr : -cr;
            const double c = (q == 0) ? cr : (q == 1) ? -sr : (q == 2) ? -cr : sr;
            rope[idx * 2] = (float)c; rope[idx * 2 + 1] = (float)s;
        }
    }
    if (gw == 0) { float* gt = (float*)(ws + WS_GTAB);
        gt[lane] = A.g_q_fox[lane]; gt[64 + lane] = A.g_k_fox[lane]; gt[128 + lane] = 1.f; gt[192 + lane] = A.g_q_dil[lane]; gt[256 + lane] = A.g_k_dil[lane]; gt[320 + lane] = 1.f; }
    f32x4 gm[4]; f32x4 wf[4][4][2];
#pragma unroll
    for (int j = 0; j < 4; ++j) { gm[j] = *(const f32x4*)(A.g_mix + 256 * j + 4 * lane);
#pragma unroll
        for (int e = 0; e < 4; ++e) { const float* wp = A.w_in + (size_t)(256 * j + 4 * lane + e) * INC + 1536; wf[j][e][0] = *(const f32x4*)wp * gm[j][e]; wf[j][e][1] = *(const f32x4*)(wp + 4) * gm[j][e]; } }
    const int hmine = ((lane >> 5) & 1) * 4 + ((lane >> 4) & 1) * 2 + ((lane >> 3) & 1);
    const float bfg = A.b_forget[hmine];
    bf16_t* XN = (bf16_t*)(ws + WS_XN); float* logf_ = (float*)(ws + WS_LOGF);
#define P0_LOAD(V, M_) do { _Pragma("unroll") for (int j = 0; j < 4; ++j) V[j] = __builtin_nontemporal_load((const f32x4*)(A.x + (size_t)(M_) * DM) + lane + 64 * j); } while (0)
#define P0_ROW(V, M_) do { \
        f32x4 v[4]; float ss = 0.f; \
        _Pragma("unroll") for (int j = 0; j < 4; ++j) v[j] = V[j]; \
        if ((M_) + 2 * NGW < MTOK) P0_LOAD(V, (M_) + 2 * NGW); \
        _Pragma("unroll") for (int j = 0; j < 4; ++j) ss += (v[j][0] * v[j][0] + v[j][1] * v[j][1]) + (v[j][2] * v[j][2] + v[j][3] * v[j][3]); \
        const float rstd = 1.f / sqrtf(wave_sum(ss) * (1.f / DM) + EPS); \
        unsigned long long* o8 = (unsigned long long*)(XN + (size_t)(M_) * DM) + lane; \
        f32x4 f0 = {0.f, 0.f, 0.f, 0.f}, f1 = {0.f, 0.f, 0.f, 0.f}; \
        _Pragma("unroll") for (int j = 0; j < 4; ++j) { \
            const f32x4 hn = v[j] * rstd * gm[j]; \
            o8[64 * j] = (unsigned long long)cvt_pk_bf16(hn[0], hn[1]) | ((unsigned long long)cvt_pk_bf16(hn[2], hn[3]) << 32); \
            _Pragma("unroll") for (int e = 0; e < 4; ++e) { f0 += wf[j][e][0] * v[j][e]; f1 += wf[j][e][1] * v[j][e]; } } \
        f32x4 k4; \
        _Pragma("unroll") for (int e = 0; e < 4; ++e) { const float send = b5 ? f0[e] : f1[e], keep = b5 ? f1[e] : f0[e]; k4[e] = keep + __shfl_xor(send, 32); } \
        float k2[2]; \
        _Pragma("unroll") for (int e = 0; e < 2; ++e) { const float send = b4 ? k4[e] : k4[2 + e], keep = b4 ? k4[2 + e] : k4[e]; k2[e] = keep + __shfl_xor(send, 16); } \
        float k1; \
        { const float send = b3 ? k2[0] : k2[1], keep = b3 ? k2[1] : k2[0]; k1 = keep + __shfl_xor(send, 8); } \
        k1 += __shfl_xor(k1, 4); k1 += __shfl_xor(k1, 2); k1 += __shfl_xor(k1, 1); \
        const float z = k1 * rstd + bfg; \
        const float lf = (z >= 0.f) ? -log1pf(__expf(-z)) : z - log1pf(__expf(z)); \
        if ((lane & 7) == 0) logf_[(size_t)(M_) * 8 + hmine] = lf; } while (0)
    const bool b5 = (lane & 32) != 0, b4 = (lane & 16) != 0, b3 = (lane & 8) != 0;
    f32x4 va[4], vb[4];
    if (gw < MTOK) P0_LOAD(va, gw);
    if (gw + NGW < MTOK) P0_LOAD(vb, gw + NGW);
    for (int m = gw; m < MTOK; m += 2 * NGW) {
        P0_ROW(va, m);
        if (m + NGW < MTOK) P0_ROW(vb, m + NGW);
    }
#undef P0_ROW
#undef P0_LOAD
}
__device__ __forceinline__ void cumsum_phase(const Args& A, int vcu, int G, int wave, int lane) {
    if (wave != 0) return;
    const float* logf_ = (const float*)(A.ws + WS_LOGF); float* c2 = (float*)(A.ws + WS_C2);
    for (int seq = vcu; seq < BATCH * 8; seq += G) {
        const int b = seq >> 3, hh = seq & 7;
        float vals[32]; float run = 0.f;
#pragma unroll
        for (int i = 0; i < 32; ++i) { run += logf_[((size_t)b * SEQ + 32 * lane + i) * 8 + hh]; vals[i] = run; }
        float inc = run;
#pragma unroll
        for (int o = 1; o < 64; o <<= 1) { const float t = __shfl_up(inc, o); if (lane >= o) inc += t; }
        const float excl = inc - run;
#pragma unroll
        for (int i = 0; i < 32; ++i) c2[(size_t)seq * SEQ + 32 * lane + i] = (excl + vals[i]) * LOG2E;
    }
}
__device__ __forceinline__ void merge_phase(const Args& A, int vcu, int G, int wave, int lane) {
    const bf16_t* OF = (const bf16_t*)(A.ws + WS_OF); const bf16_t* OD = (const bf16_t*)(A.ws + WS_OD); const float* LSE = (const float*)(A.ws + WS_LSE); bf16_t* ON = (bf16_t*)(A.ws + WS_ON);
    const int gw = vcu * NWAVES + wave, NGW = G * NWAVES;
    float gf[8], gd[8];
    { const f32x4 a = *(const f32x4*)(A.g_out_fox + 8 * lane), b = *(const f32x4*)(A.g_out_fox + 8 * lane + 4), c = *(const f32x4*)(A.g_out_dil + 8 * lane), d = *(const f32x4*)(A.g_out_dil + 8 * lane + 4);
#pragma unroll
      for (int e = 0; e < 4; ++e) { gf[e] = a[e]; gf[4 + e] = b[e]; gd[e] = c[e]; gd[4 + e] = d[e]; } }
    u32x4 fwn, dwn[3]; float lsn[3];
#define MERGE_LOAD(M_) do { fwn = __builtin_nontemporal_load((const u32x4*)(OF + (size_t)(M_) * 512 + 8 * lane)); \
        _Pragma("unroll") for (int i = 0; i < 3; ++i) { dwn[i] = __builtin_nontemporal_load((const u32x4*)(OD + (size_t)i * OD_STRIDE + (size_t)(M_) * 512 + 8 * lane)); lsn[i] = LSE[((size_t)i * MTOK + (M_)) * 8 + (lane >> 3)]; } } while (0)
    if (gw < MTOK) MERGE_LOAD(gw);
    for (int m = gw; m < MTOK; m += NGW) {
        const u32x4 fw = fwn; u32x4 dwc[3]; float ls[3];
#pragma unroll
        for (int i = 0; i < 3; ++i) { dwc[i] = dwn[i]; ls[i] = lsn[i]; }
        if (m + NGW < MTOK) MERGE_LOAD(m + NGW);
        float of[8], od[8] = {0.f, 0.f, 0.f, 0.f, 0.f, 0.f, 0.f, 0.f};
#pragma unroll
        for (int e = 0; e < 4; ++e) { of[2 * e] = __uint_as_float(fw[e] << 16); of[2 * e + 1] = __uint_as_float(fw[e] & 0xffff0000u); }
        const float mx = fmaxf(ls[0], fmaxf(ls[1], ls[2]));
        float wsum = 0.f;
#pragma unroll
        for (int i = 0; i < 3; ++i) {
            const float w = __builtin_amdgcn_exp2f(ls[i] - mx); wsum += w;
            const u32x4 dw = dwc[i];
#pragma unroll
            for (int e = 0; e < 4; ++e) { od[2 * e] += w * __uint_as_float(dw[e] << 16); od[2 * e + 1] += w * __uint_as_float(dw[e] & 0xffff0000u); }
        }
        const float iw = 1.f / wsum; float sf = 0.f, sd = 0.f;
#pragma unroll
        for (int e = 0; e < 8; ++e) { od[e] *= iw; sf += of[e] * of[e]; sd += od[e] * od[e]; }
        const float rf = 1.f / sqrtf(wave_sum(sf) * (1.f / 512.f) + EPS), rd = 1.f / sqrtf(wave_sum(sd) * (1.f / 512.f) + EPS);
        u32x4 a, b;
        a.x = cvt_pk_bf16(of[0] * rf * gf[0], of[1] * rf * gf[1]); a.y = cvt_pk_bf16(of[2] * rf * gf[2], of[3] * rf * gf[3]); a.z = cvt_pk_bf16(of[4] * rf * gf[4], of[5] * rf * gf[5]); a.w = cvt_pk_bf16(of[6] * rf * gf[6], of[7] * rf * gf[7]);
        b.x = cvt_pk_bf16(od[0] * rd * gd[0], od[1] * rd * gd[1]); b.y = cvt_pk_bf16(od[2] * rd * gd[2], od[3] * rd * gd[3]); b.z = cvt_pk_bf16(od[4] * rd * gd[4], od[5] * rd * gd[5]); b.w = cvt_pk_bf16(od[6] * rd * gd[6], od[7] * rd * gd[7]);
        *(u32x4*)(ON + (size_t)m * DM + 8 * lane) = a;
        *(u32x4*)(ON + (size_t)m * DM + 512 + 8 * lane) = b;
    }
}

namespace att {
typedef short bf16x8 __attribute__((ext_vector_type(8)));
typedef short s16x4 __attribute__((ext_vector_type(4)));
typedef float f32x16 __attribute__((ext_vector_type(16)));
typedef float f32x2_t __attribute__((ext_vector_type(2)));
typedef __bf16 bf16x2_t __attribute__((ext_vector_type(2)));
constexpr int KP = 144, TILE_B = 64 * KP, BUF_B = 2 * TILE_B + 256, DIL_V = 384 * KP;
constexpr float NEGBIG = -1e30f;
constexpr int NUNITS = 36 * 256;
__device__ __forceinline__ unsigned cvtpk(float lo, float hi) { f32x2_t v = {lo, hi}; bf16x2_t b = __builtin_convertvector(v, bf16x2_t); return __builtin_bit_cast(unsigned, b); }
__device__ __forceinline__ s16x4 vtr(const LAS unsigned char* p) { return __builtin_bit_cast(s16x4, __builtin_amdgcn_ds_read_tr16_b64_v4i16((LAS s16x4*)p)); }
#define ATT_MFMA(a, b, c) __builtin_amdgcn_mfma_f32_32x32x16_bf16((a), (b), (c), 0, 0, 0)

__device__ __forceinline__ void mask_blk(f32x16& s0, f32x16& s1, int bs, int W) {
#pragma unroll
    for (int i = 0; i < 16; ++i) { const int off = (i & 3) + 8 * (i >> 2);
        if ((unsigned)(bs - off) > (unsigned)W) s0[i] = NEGBIG;
        if ((unsigned)(bs - 32 - off) > (unsigned)W) s1[i] = NEGBIG; }
}
__device__ __forceinline__ void softmax_blk(f32x16& t0, f32x16& t1, float& m, float& l, f32x16& o0, f32x16& o1, u32x4 (&pw)[4]) {
    int im = max(__float_as_int(t0[0]), __float_as_int(t1[0]));
#pragma unroll
    for (int i = 1; i < 16; ++i) im = max(im, max(__float_as_int(t0[i]), __float_as_int(t1[i])));
    { auto rr = __builtin_amdgcn_permlane32_swap((unsigned)im, (unsigned)im, false, false); im = max((int)rr[0], (int)rr[1]); }
    if (__builtin_amdgcn_ballot_w64(im > 0x41000000) != 0ull) {
        float mx = fmaxf(t0[0], t1[0]);
#pragma unroll
        for (int i = 1; i < 16; ++i) mx = fmaxf(mx, fmaxf(t0[i], t1[i]));
        { auto rr = __builtin_amdgcn_permlane32_swap(__float_as_uint(mx), __float_as_uint(mx), false, false); mx = fmaxf(__uint_as_float(rr[0]), __uint_as_float(rr[1])); }
        const float dl = fmaxf(mx, 0.f), al = __builtin_amdgcn_exp2f(-dl);
        m += dl; l *= al;
#pragma unroll
        for (int i = 0; i < 16; ++i) { t0[i] -= dl; t1[i] -= dl; o0[i] *= al; o1[i] *= al; }
    }
    float ps = 0.f;
#pragma unroll
    for (int i = 0; i < 16; ++i) { t0[i] = __builtin_amdgcn_exp2f(t0[i]); t1[i] = __builtin_amdgcn_exp2f(t1[i]); ps += t0[i] + t1[i]; }
    l += ps;
#pragma unroll
    for (int sp = 0; sp < 2; ++sp) {
        pw[sp].x = cvtpk(t0[8 * sp], t0[8 * sp + 1]); pw[sp].y = cvtpk(t0[8 * sp + 2], t0[8 * sp + 3]); pw[sp].z = cvtpk(t0[8 * sp + 4], t0[8 * sp + 5]); pw[sp].w = cvtpk(t0[8 * sp + 6], t0[8 * sp + 7]);
        pw[2 + sp].x = cvtpk(t1[8 * sp], t1[8 * sp + 1]); pw[2 + sp].y = cvtpk(t1[8 * sp + 2], t1[8 * sp + 3]); pw[2 + sp].z = cvtpk(t1[8 * sp + 4], t1[8 * sp + 5]); pw[2 + sp].w = cvtpk(t1[8 * sp + 6], t1[8 * sp + 7]);
    }
}
__device__ __forceinline__ void store_blk(const f32x16& o0, const f32x16& o1, float m, float l, bf16_t* op, float* lp, int h) {
    float lt = l;
    { auto rr = __builtin_amdgcn_permlane32_swap(__float_as_uint(l), __float_as_uint(l), false, false); lt = __uint_as_float(rr[0]) + __uint_as_float(rr[1]); }
    const float il = 1.f / lt;
#pragma unroll
    for (int k = 0; k < 2; ++k) {
        {
            unsigned a0 = cvtpk(o0[8 * k] * il, o0[8 * k + 1] * il), a1 = cvtpk(o0[8 * k + 2] * il, o0[8 * k + 3] * il), b0 = cvtpk(o0[8 * k + 4] * il, o0[8 * k + 5] * il), b1 = cvtpk(o0[8 * k + 6] * il, o0[8 * k + 7] * il);
            auto r0 = __builtin_amdgcn_permlane32_swap(a0, b0, false, false); auto r1 = __builtin_amdgcn_permlane32_swap(a1, b1, false, false);
            u32x4 w; w.x = r0[0]; w.y = r1[0]; w.z = r0[1]; w.w = r1[1];
            *(u32x4*)(op + 16 * k + 8 * h) = w;
        }
        {
            unsigned a0 = cvtpk(o1[8 * k] * il, o1[8 * k + 1] * il), a1 = cvtpk(o1[8 * k + 2] * il, o1[8 * k + 3] * il), b0 = cvtpk(o1[8 * k + 4] * il, o1[8 * k + 5] * il), b1 = cvtpk(o1[8 * k + 6] * il, o1[8 * k + 7] * il);
            auto r0 = __builtin_amdgcn_permlane32_swap(a0, b0, false, false); auto r1 = __builtin_amdgcn_permlane32_swap(a1, b1, false, false);
            u32x4 w; w.x = r0[0]; w.y = r1[0]; w.z = r0[1]; w.w = r1[1];
            *(u32x4*)(op + 32 + 16 * k + 8 * h) = w;
        }
    }
    if (lp && h == 0) *lp = m + __builtin_amdgcn_logf(lt);
}

__device__ __forceinline__ void fox_unit(LAS unsigned char* lds, const bf16_t* __restrict__ QKV, const float* __restrict__ c2, bf16_t* __restrict__ Oout, int bh, int p0, int tid, int lane, int wave) {
    const int b = bh >> 3, hh = bh & 7, r32 = lane & 31, h = lane >> 5;
    const bf16_t* base = QKV + (size_t)bh * HSTRIDE;
    const float* cc = c2 + (size_t)bh * SEQ;
    const int wqA = p0 + 32 * wave, wqB = p0 + 32 * (15 - wave), tA = wqA >> 6, tB = wqB >> 6;
    bf16x8 qfA[4], qfB[4];
#pragma unroll
    for (int ks = 0; ks < 4; ++ks) { qfA[ks] = *(const bf16x8*)(base + (size_t)(wqA + r32) * 64 + 16 * ks + 8 * h); qfB[ks] = *(const bf16x8*)(base + (size_t)(wqB + r32) * 64 + 16 * ks + 8 * h); }
    const float cqA = cc[wqA + r32], cqB = cc[wqB + r32];
    const int n_st = (p0 + 512) >> 7;
    const int skey = tid >> 3, sch = tid & 7;
    const bf16_t* gk = base + SECS + (size_t)skey * 64 + sch * 8;
    const size_t tstep = (size_t)64 * 64;
    const int soff = skey * KP + sch * 16, coff = (tid >> 6) * BUF_B + 2 * TILE_B + (tid & 63) * 4;
    u32x4 kreg0 = *(const u32x4*)gk, vreg0 = *(const u32x4*)(gk + SECS), kreg1 = *(const u32x4*)(gk + tstep), vreg1 = *(const u32x4*)(gk + tstep + SECS); float creg = 0.f;
    if (tid < 128) creg = cc[tid];
    *(LAS u32x4*)(lds + soff) = kreg0; *(LAS u32x4*)(lds + TILE_B + soff) = vreg0; *(LAS u32x4*)(lds + BUF_B + soff) = kreg1; *(LAS u32x4*)(lds + BUF_B + TILE_B + soff) = vreg1;
    if (tid < 128) *(LAS float*)(lds + coff) = creg;
    __syncthreads();
    float mA = 0.f, lA = 0.f, mB = 0.f, lB = 0.f; f32x16 oA0, oA1, oB0, oB1;
#pragma unroll
    for (int i = 0; i < 16; ++i) { oA0[i] = 0.f; oA1[i] = 0.f; oB0[i] = 0.f; oB1[i] = 0.f; }
    const int i16 = lane & 15, vq = i16 >> 2, vp = i16 & 3, vblk = (lane >> 4) & 1;
    const int voff = (4 * h + vq) * KP + (16 * vblk + 4 * vp) * 2;
    for (int st = 0; st < n_st; ++st) {
        const int cur = st & 1; const bool more = st + 1 < n_st;
        if (more) { const bf16_t* gn = gk + (size_t)(2 * st + 2) * tstep; kreg0 = *(const u32x4*)gn; vreg0 = *(const u32x4*)(gn + SECS); kreg1 = *(const u32x4*)(gn + tstep); vreg1 = *(const u32x4*)(gn + tstep + SECS);
                    if (tid < 128) creg = cc[(st + 1) * 128 + tid]; }
#pragma unroll 1
        for (int sub = 0; sub < 2; ++sub) {
        const int tk0 = st * 128 + sub * 64, tix = 2 * st + sub;
        if (tix <= tB) {
            const bool doA = tix <= tA;
            const LAS unsigned char* kb_ = lds + (cur * 2 + sub) * BUF_B; const LAS unsigned char* vb_ = kb_ + TILE_B; const LAS float* cb_ = (const LAS float*)(kb_ + 2 * TILE_B);
            f32x16 sA0, sA1, sB0, sB1;
            { const float cmA = cqA - mA, cmB = cqB - mB;
#pragma unroll
            for (int g = 0; g < 4; ++g) { const f32x4 c0 = *(const LAS f32x4*)(cb_ + 8 * g + 4 * h), c1 = *(const LAS f32x4*)(cb_ + 32 + 8 * g + 4 * h);
#pragma unroll
                for (int e = 0; e < 4; ++e) { sA0[4 * g + e] = cmA - c0[e]; sA1[4 * g + e] = cmA - c1[e]; sB0[4 * g + e] = cmB - c0[e]; sB1[4 * g + e] = cmB - c1[e]; } } }
#pragma unroll
            for (int kh = 0; kh < 2; ++kh) { bf16x8 kf[4];
#pragma unroll
                for (int k2 = 0; k2 < 2; ++k2) { const int ks = 2 * kh + k2; kf[2 * k2] = *(const LAS bf16x8*)(kb_ + r32 * KP + (16 * ks + 8 * h) * 2); kf[2 * k2 + 1] = *(const LAS bf16x8*)(kb_ + (32 + r32) * KP + (16 * ks + 8 * h) * 2); }
                __builtin_amdgcn_sched_barrier(0);
#pragma unroll
                for (int k2 = 0; k2 < 2; ++k2) { const int ks = 2 * kh + k2; sB0 = ATT_MFMA(kf[2 * k2], qfB[ks], sB0); sB1 = ATT_MFMA(kf[2 * k2 + 1], qfB[ks], sB1); }
                if (doA) {
#pragma unroll
                    for (int k2 = 0; k2 < 2; ++k2) { const int ks = 2 * kh + k2; sA0 = ATT_MFMA(kf[2 * k2], qfA[ks], sA0); sA1 = ATT_MFMA(kf[2 * k2 + 1], qfA[ks], sA1); }
                }
            }
            if (tix == tB) mask_blk(sB0, sB1, wqB + r32 - tk0 - 4 * h, 4096);
            u32x4 pA[4], pB[4];
            if (doA) {
                if (tix == tA) mask_blk(sA0, sA1, wqA + r32 - tk0 - 4 * h, 4096);
                softmax_blk(sA0, sA1, mA, lA, oA0, oA1, pA);
            }
            softmax_blk(sB0, sB1, mB, lB, oB0, oB1, pB);
#pragma unroll
            for (int idx = 0; idx < 4; ++idx) {
                const LAS unsigned char* vp_ = vb_ + (16 * idx) * KP + voff;
                const s16x4 a0 = vtr(vp_), a1 = vtr(vp_ + 8 * KP), b0 = vtr(vp_ + 64), b1 = vtr(vp_ + 8 * KP + 64);
                const bf16x8 vf0 = __builtin_shufflevector(a0, a1, 0, 1, 2, 3, 4, 5, 6, 7), vf1 = __builtin_shufflevector(b0, b1, 0, 1, 2, 3, 4, 5, 6, 7);
                const bf16x8 pfB = __builtin_bit_cast(bf16x8, pB[idx]);
                oB0 = ATT_MFMA(vf0, pfB, oB0); oB1 = ATT_MFMA(vf1, pfB, oB1);
                if (doA) { const bf16x8 pfA = __builtin_bit_cast(bf16x8, pA[idx]); oA0 = ATT_MFMA(vf0, pfA, oA0); oA1 = ATT_MFMA(vf1, pfA, oA1); }
            }
        }
        }
        if (more) { const int nb = (cur ^ 1) * 2 * BUF_B; *(LAS u32x4*)(lds + nb + soff) = kreg0; *(LAS u32x4*)(lds + nb + TILE_B + soff) = vreg0; *(LAS u32x4*)(lds + nb + BUF_B + soff) = kreg1; *(LAS u32x4*)(lds + nb + BUF_B + TILE_B + soff) = vreg1;
                    if (tid < 128) *(LAS float*)(lds + nb + coff) = creg; }
        __syncthreads();
    }
    store_blk(oA0, oA1, mA, lA, Oout + ((size_t)b * SEQ + wqA + r32) * 512 + hh * 64, nullptr, h);
    store_blk(oB0, oB1, mB, lB, Oout + ((size_t)b * SEQ + wqB + r32) * 512 + hh * 64, nullptr, h);
}
struct DilDesc { int bh, br, dd, p0, klo, nkt, rr0; };
__device__ __forceinline__ DilDesc dil_desc(int k, int vcu, int G) {
    DilDesc d; int i;
    if (G == 256) { const int xcd = vcu >> 5, c = vcu & 31, g = k / 3, sub = k - 3 * g; d.bh = 32 * xcd + 4 * g + (c >> 3); i = (c & 7) + 8 * sub; }
    else { const int u = vcu + k * G; d.bh = u & 255; i = u >> 8; }
    if (i < 8) { d.br = 0; d.dd = 1; d.p0 = 256 * i; d.rr0 = 0; }
    else if (i < 16) { d.br = 1; d.dd = 4; d.p0 = 256 * ((i - 8) & 1); d.rr0 = (i - 8) >> 1; }
    else { d.br = 2; d.dd = 16; d.p0 = 0; d.rr0 = 2 * (i - 16); }
    d.klo = d.p0 >= 128 ? d.p0 - 128 : 0; d.nkt = d.br == 2 ? 4 : (d.p0 + 256 - d.klo) >> 6;
    return d;
}
__device__ __forceinline__ void dil_compute(const LAS unsigned char* lds, const DilDesc& c, const bf16x8 (&qf)[4], int wave, int r32, int h, int voff, f32x16& o0, f32x16& o1, float& m, float& l, size_t& qrow) {
    const int seg = c.br == 2 ? (wave >> 2) : 0, wq0 = c.br == 2 ? 32 * (wave & 3) : c.p0 + 32 * wave, rr = c.rr0 + seg, klo = c.br == 2 ? 0 : c.klo;
    const LAS unsigned char* segb = lds + seg * 2 * TILE_B;
    m = 0.f; l = 0.f;
#pragma unroll
    for (int i = 0; i < 16; ++i) { o0[i] = 0.f; o1[i] = 0.f; }
    const int t_lo = (wq0 >= 128 ? wq0 - 128 : 0) >> 6, t_hi = wq0 >> 6;
    for (int t = t_lo; t <= t_hi; ++t) {
        const int tk0 = t * 64;
        const LAS unsigned char* kb_ = segb + (tk0 - klo) * KP; const LAS unsigned char* vb_ = kb_ + DIL_V;
        f32x16 s0, s1;
#pragma unroll
        for (int i = 0; i < 16; ++i) { s0[i] = -m; s1[i] = -m; }
#pragma unroll
        for (int kh = 0; kh < 2; ++kh) { bf16x8 kf[4];
#pragma unroll
            for (int k2 = 0; k2 < 2; ++k2) { const int ks = 2 * kh + k2; kf[2 * k2] = *(const LAS bf16x8*)(kb_ + r32 * KP + (16 * ks + 8 * h) * 2); kf[2 * k2 + 1] = *(const LAS bf16x8*)(kb_ + (32 + r32) * KP + (16 * ks + 8 * h) * 2); }
            __builtin_amdgcn_sched_barrier(0);
#pragma unroll
            for (int k2 = 0; k2 < 2; ++k2) { const int ks = 2 * kh + k2; s0 = ATT_MFMA(kf[2 * k2], qf[ks], s0); s1 = ATT_MFMA(kf[2 * k2 + 1], qf[ks], s1); }
        }
        if (tk0 + 63 > wq0 || wq0 + 31 - tk0 > 128) mask_blk(s0, s1, wq0 + r32 - tk0 - 4 * h, 128);
        u32x4 pw[4];
        softmax_blk(s0, s1, m, l, o0, o1, pw);
#pragma unroll
        for (int idx = 0; idx < 4; ++idx) {
            const LAS unsigned char* vp_ = vb_ + (16 * idx) * KP + voff;
            const s16x4 a0 = vtr(vp_), a1 = vtr(vp_ + 8 * KP), b0 = vtr(vp_ + 64), b1 = vtr(vp_ + 8 * KP + 64);
            const bf16x8 vf0 = __builtin_shufflevector(a0, a1, 0, 1, 2, 3, 4, 5, 6, 7), vf1 = __builtin_shufflevector(b0, b1, 0, 1, 2, 3, 4, 5, 6, 7);
            const bf16x8 pf = __builtin_bit_cast(bf16x8, pw[idx]);
            o0 = ATT_MFMA(vf0, pf, o0); o1 = ATT_MFMA(vf1, pf, o1);
        }
    }
    qrow = (size_t)(c.bh >> 3) * SEQ + (size_t)(wq0 + r32) * c.dd + rr;
}
__device__ __forceinline__ void dil_phase(LAS unsigned char* lds, const bf16_t* __restrict__ QKV, bf16_t* __restrict__ OD, float* __restrict__ LSE, int vcu, int G, int tid, int lane, int wave) {
    const int r32 = lane & 31, h = lane >> 5, skey = tid >> 3, sch = tid & 7, soff = skey * KP + sch * 16;
    const int i16 = lane & 15, vq = i16 >> 2, vp = i16 & 3, vblk = (lane >> 4) & 1;
    const int voff = (4 * h + vq) * KP + (16 * vblk + 4 * vp) * 2;
    const int nsteps = (G == 256) ? 24 : (24 * 256 - vcu + G - 1) / G;
    if (nsteps <= 0) return;
    u32x4 krA[6], vrA[6], krB[6], vrB[6]; bf16x8 qnA[4], qnB[4];
    DilDesc dA = dil_desc(0, vcu, G), dB = dA;
#define DIL_ISSUE(D, KR, VR, QN) do { \
        const bf16_t* base_ = QKV + (size_t)(3 * 256 + (D).bh) * HSTRIDE; \
        _Pragma("unroll") for (int j = 0; j < 6; ++j) if (j < (D).nkt) { \
            const int kpos_ = (D).br == 2 ? 64 * (j & 1) : (D).klo + 64 * j, rr_ = (D).br == 2 ? (D).rr0 + (j >> 1) : (D).rr0; \
            const bf16_t* g_ = base_ + SECS + (size_t)((kpos_ + skey) * (D).dd + rr_) * 64 + sch * 8; \
            KR[j] = *(const u32x4*)g_; VR[j] = *(const u32x4*)(g_ + SECS); } \
        { const int seg_ = (D).br == 2 ? (wave >> 2) : 0, wq_ = (D).br == 2 ? 32 * (wave & 3) : (D).p0 + 32 * wave; \
          const bf16_t* q_ = base_ + (size_t)((wq_ + r32) * (D).dd + (D).rr0 + seg_) * 64 + 8 * h; \
          _Pragma("unroll") for (int ks = 0; ks < 4; ++ks) QN[ks] = *(const bf16x8*)(q_ + 16 * ks); } } while (0)
    DIL_ISSUE(dA, krA, vrA, qnA);
    if (nsteps > 1) { dB = dil_desc(1, vcu, G); DIL_ISSUE(dB, krB, vrB, qnB); }
    bool pend = false; f32x16 po0, po1; float pm = 0.f, pl = 1.f; bf16_t* pop = OD; float* plp = LSE;
#pragma unroll
    for (int i = 0; i < 16; ++i) { po0[i] = 0.f; po1[i] = 0.f; }
#define DIL_STEP(D, KR, VR, QN, KIDX) do { \
        _Pragma("unroll") for (int j = 0; j < 6; ++j) if (j < (D).nkt) { *(LAS u32x4*)(lds + j * TILE_B + soff) = KR[j]; *(LAS u32x4*)(lds + DIL_V + j * TILE_B + soff) = VR[j]; } \
        bf16x8 qf[4]; \
        _Pragma("unroll") for (int ks = 0; ks < 4; ++ks) qf[ks] = QN[ks]; \
        __syncthreads(); \
        const DilDesc c = (D); \
        if ((KIDX) + 2 < nsteps) { (D) = dil_desc((KIDX) + 2, vcu, G); DIL_ISSUE((D), KR, VR, QN); } \
        if (pend) store_blk(po0, po1, pm, pl, pop, plp, h); \
        size_t qrow; \
        dil_compute(lds, c, qf, wave, r32, h, voff, po0, po1, pm, pl, qrow); pend = true; \
        pop = OD + (size_t)c.br * OD_STRIDE + qrow * 512 + (c.bh & 7) * 64; plp = LSE + (size_t)c.br * MTOK * 8 + qrow * 8 + (c.bh & 7); \
        __syncthreads(); } while (0)
    for (int k = 0; k < nsteps; k += 2) {
        DIL_STEP(dA, krA, vrA, qnA, k);
        if (k + 1 >= nsteps) break;
        DIL_STEP(dB, krB, vrB, qnB, k + 1);
    }
    if (pend) store_blk(po0, po1, pm, pl, pop, plp, h);
#undef DIL_STEP
#undef DIL_ISSUE
}
__device__ __forceinline__ void attn_phase(LAS unsigned char* lds, unsigned char* ws, int vcu, int G, int tid, int lane, int wave) {
    const bf16_t* QKV = (const bf16_t*)(ws + WS_QKV); const float* c2 = (const float*)(ws + WS_C2);
    bf16_t* OF = (bf16_t*)(ws + WS_OF); bf16_t* OD = (bf16_t*)(ws + WS_OD); float* LSE = (float*)(ws + WS_LSE);
    for (int u = vcu; u < 4 * 256; u += G) fox_unit(lds, QKV, c2, OF, u & 255, (3 - (u >> 8)) * 512, tid, lane, wave);
    dil_phase(lds, QKV, OD, LSE, vcu, G, tid, lane, wave);
}
}

#define RLX_AGENT __ATOMIC_RELAXED, __HIP_MEMORY_SCOPE_AGENT
#define XB_TMO      128
#define XB_XCNT(j)  (256  + 64 * (j))
#define XB_XSUB(j)  (1280 + 64 * (j))
#define XB_XGEN(j)  (2304 + 64 * (j))
#define XB_TOP      3328
#define XB_TOPGEN   3392
#define XCD_BAR_WORDS 3456
#define XB_SPIN_CAP (1u << 18)

__device__ __forceinline__ unsigned xb_ld(unsigned* p)              { return __hip_atomic_load(p, __ATOMIC_RELAXED, __HIP_MEMORY_SCOPE_AGENT); }
__device__ __forceinline__ unsigned xb_add(unsigned* p, unsigned v) { return __hip_atomic_fetch_add(p, v, __ATOMIC_RELAXED, __HIP_MEMORY_SCOPE_AGENT); }
__device__ __forceinline__ unsigned xb_xcc_id() { return (unsigned)__builtin_amdgcn_s_getreg((3 << 11) | 20) & 0xFu; }
#define XB_SPIN(cond, bar) do { unsigned _sp = 0; while (cond) { __builtin_amdgcn_s_sleep(1); \
    if ((++_sp & 255u) == 0u) { if (xb_ld(&(bar)[XB_TMO])) break; if (_sp > XB_SPIN_CAP) { atomicAdd(&(bar)[XB_TMO], 1u); break; } } } } while (0)

struct XcdBarrier {
    unsigned* bar; unsigned x;
    volatile LAS unsigned* st;
};

__device__ __forceinline__ XcdBarrier xcd_barrier_post(unsigned* bar, volatile LAS unsigned* st) {
    XcdBarrier b; b.bar = bar; b.x = xb_xcc_id(); b.st = st;
    if (threadIdx.x == 0) (void)xb_add(&bar[XB_XCNT(b.x)], 1u);
    return b;
}
__device__ __forceinline__ void xcd_barrier_complete(unsigned* bar, unsigned x, unsigned& nloc, unsigned& nx) {
    const unsigned G = gridDim.x * gridDim.y * gridDim.z;
    unsigned sum, cnt, mine, sp = 0u;
    for (;;) {
        sum = 0u; cnt = 0u; mine = 0u;
#pragma unroll
        for (unsigned j = 0; j < 16; ++j) { const unsigned c = xb_ld(&bar[XB_XCNT(j)]); sum += c; cnt += (c > 0u) ? 1u : 0u; mine = (j == x) ? c : mine; }
        if (sum == G) break;
        __builtin_amdgcn_s_sleep(1);
        if ((++sp & 255u) == 0u) { if (xb_ld(&bar[XB_TMO])) break; if (sp > XB_SPIN_CAP) { atomicAdd(&bar[XB_TMO], 1u); break; } }
    }
    nloc = mine > 0u ? mine : 1u; nx = cnt > 0u ? cnt : 1u;
}

__device__ __forceinline__ void xcd_barrier(const XcdBarrier& b) {
    asm volatile("s_waitcnt vmcnt(0)" ::: "memory");
    __syncthreads();
    if (threadIdx.x == 0) {
        unsigned* bar = b.bar;
        __builtin_amdgcn_s_waitcnt(0);
        unsigned nloc = b.st[0], nx = b.st[1];
        if (nloc == 0u) { xcd_barrier_complete(bar, b.x, nloc, nx); b.st[0] = nloc; b.st[1] = nx; }
        const unsigned old = xb_add(&bar[XB_XSUB(b.x)], 1u);
        const unsigned gen = old / nloc;
        if (old + 1u == (gen + 1u) * nloc) {
            __builtin_amdgcn_fence(__ATOMIC_RELEASE, "agent");
            asm volatile("s_waitcnt vmcnt(0)" ::: "memory");
            const unsigned og = xb_add(&bar[XB_TOP], 1u);
            const unsigned tg = og / nx;
            if (og + 1u == (tg + 1u) * nx) xb_add(&bar[XB_TOPGEN], 1u);
            else XB_SPIN(xb_ld(&bar[XB_TOPGEN]) == tg, bar);
            __builtin_amdgcn_fence(__ATOMIC_ACQUIRE, "agent");
            xb_add(&bar[XB_XGEN(b.x)], 1u);
            asm volatile("s_waitcnt vmcnt(0)" ::: "memory");
        } else {
            XB_SPIN(xb_ld(&bar[XB_XGEN(b.x)]) == gen, bar);
            __builtin_amdgcn_fence(__ATOMIC_ACQUIRE, "agent");
            asm volatile("s_waitcnt vmcnt(0)" ::: "memory");
        }
    }
    __syncthreads();
}

__global__ void __launch_bounds__(NTHREADS, 2) fwd_kernel(Args A) {
    extern __shared__ __attribute__((aligned(16))) unsigned char lds_raw[];
    LAS unsigned char* lds = (LAS unsigned char*)lds_raw;
    const int tid = threadIdx.x, lane = tid & 63, wave = __builtin_amdgcn_readfirstlane(tid >> 6);
    const int G = gridDim.x, bx = blockIdx.x, vcu = (G % 8 == 0) ? (bx % 8) * (G / 8) + bx / 8 : bx;
    unsigned char* ws = A.ws;
    const int lo = A.ph_lo, hi = A.ph_hi;
    volatile LAS unsigned* bst = (volatile LAS unsigned*)(lds + 131072);
    if (tid < 2) bst[tid] = 0u;
    __syncthreads();
    XcdBarrier bar = xcd_barrier_post((unsigned*)(ws + WS_CTL), bst);
#define IN(k) (lo <= (k) && (k) < hi)
#define SEAM(k) do { if (IN(k) && IN((k) + 1)) { xcd_barrier(bar); } } while (0)
    if (lo > 90) cg::this_grid().sync();
    if (IN(0)) { p0_prologue(A, lds, vcu, G, wave, lane); } SEAM(0);
    if (IN(1)) {
        cumsum_phase(A, vcu, G, wave, lane);
        pg8::Gemm g{(const bf16_t*)(ws + WS_XN), (const bf16_t*)(ws + WS_WQKV), MTOK, NQKV, DM}; pg8::StaticOrder S; S.init(MTOK, NQKV, G, bx);
        EpiQKV E{(bf16_t*)(ws + WS_QKV), (const float*)(ws + WS_GTAB), (const float*)(ws + WS_ROPE)};
        pg8::gemm_phase<EpiQKV, pg8::StaticOrder, true, true>(lds, g, S, E);
    } SEAM(1);
    if (IN(2)) {
        att::attn_phase(lds, ws, vcu, G, tid, lane, wave);
    } SEAM(2);
    if (IN(3)) { merge_phase(A, vcu, G, wave, lane); } SEAM(3);
    if (IN(4)) {
        pg8::Gemm g{(const bf16_t*)(ws + WS_ON), (const bf16_t*)(ws + WS_WO), MTOK, DM, DM}; pg8::StaticOrder S; S.init(MTOK, DM, G, bx);
        EpiOut E{A.x, (bf16_t*)(ws + WS_X1B), (float*)(ws + WS_SSQ)};
        pg8::gemm_phase<EpiOut, pg8::StaticOrder, true, true>(lds, g, S, E);
    } SEAM(4);
    if (IN(5)) {
        pg8::Gemm g{(const bf16_t*)(ws + WS_X1B), (const bf16_t*)(ws + WS_WGU), MTOK, NGU, DM}; pg8::StaticOrder S; S.init(MTOK, NGU, G, bx);
        EpiGU E{(bf16_t*)(ws + WS_H), (const float*)(ws + WS_SSQ), (LAS float*)(lds + 131072 + 256), -1};
        pg8::gemm_phase<EpiGU, pg8::StaticOrder, true, true>(lds, g, S, E);
    } SEAM(5);
    if (IN(6)) {
        pg8::Gemm g{(const bf16_t*)(ws + WS_H), (const bf16_t*)(ws + WS_WD), MTOK, DM, FF}; pg8::StaticOrder S; S.init(MTOK, DM, G, bx);
        EpiDown E{A.out, (const bf16_t*)(ws + WS_X1B)};
        pg8::gemm_phase<EpiDown, pg8::StaticOrder, true, true>(lds, g, S, E);
    }
#undef IN
#undef SEAM
}

extern "C" void kernel_launch(void* const* d_in, const int* in_sizes, int n_in, void* d_out, int out_size, void* d_ws, size_t ws_size, hipStream_t stream) {
    static int grid = 0;
    if (grid == 0) {
        if (n_in != 15 || out_size != MTOK * DM || ws_size < WS_END) { fprintf(stderr, "kernel_launch: unexpected shapes (n_in %d out %d ws %zu)\n", n_in, out_size, ws_size); grid = -1; return; }
        if (hipFuncSetAttribute((const void*)fwd_kernel, hipFuncAttributeMaxDynamicSharedMemorySize, LDS_BYTES) != hipSuccess) { fprintf(stderr, "kernel_launch: hipFuncSetAttribute failed\n"); grid = -1; return; }
        int dev = 0, cus = 0, per_cu = 0;
        hipGetDevice(&dev); hipDeviceGetAttribute(&cus, hipDeviceAttributeMultiprocessorCount, dev);
        hipOccupancyMaxActiveBlocksPerMultiprocessor(&per_cu, (const void*)fwd_kernel, NTHREADS, LDS_BYTES);
        (void)hipGetLastError();
        grid = (cus > 0 ? cus : 256) * (per_cu > 0 ? per_cu : 1);
        fprintf(stderr, "kernel_launch: cus %d per_cu %d grid %d\n", cus, per_cu, grid);
    }
    if (grid < 0) return;
    Args a{};
    a.x = (const float*)d_in[0]; a.g_mix = (const float*)d_in[1]; a.w_in = (const float*)d_in[2]; a.b_forget = (const float*)d_in[3]; a.g_q_fox = (const float*)d_in[4]; a.g_k_fox = (const float*)d_in[5];
    a.g_q_dil = (const float*)d_in[6]; a.g_k_dil = (const float*)d_in[7]; a.g_out_fox = (const float*)d_in[8]; a.g_out_dil = (const float*)d_in[9]; a.w_out = (const float*)d_in[10]; a.g_ffn = (const float*)d_in[11];
    a.w_gate = (const float*)d_in[12]; a.w_up = (const float*)d_in[13]; a.w_down = (const float*)d_in[14];
    a.out = (float*)d_out; a.ws = (unsigned char*)d_ws;
    a.ph_lo = 0; a.ph_hi = 7;
    if (hipMemsetAsync((unsigned char*)d_ws + WS_CTL, 0, CTL_BYTES, stream) != hipSuccess) { fprintf(stderr, "kernel_launch: memset failed\n"); return; }
    void* kargs[] = {&a};
    hipError_t e = hipLaunchCooperativeKernel((const void*)fwd_kernel, dim3(grid), dim3(NTHREADS), kargs, LDS_BYTES, stream);
    if (e != hipSuccess) fprintf(stderr, "kernel_launch: cooperative launch failed: %s (grid %d)\n", hipGetErrorString(e), grid);
}
```

```cpp
#include <hip/hip_runtime.h>
#include <hip/hip_cooperative_groups.h>
#include <cstdio>
#include <cstdint>
namespace cg = cooperative_groups;
namespace pg8 {
#define PG8_LAS __attribute__((address_space(3)))
typedef unsigned short bf16_t;
typedef short bf16x8 __attribute__((ext_vector_type(8)));
typedef float f32x4 __attribute__((ext_vector_type(4)));
typedef unsigned u32x4 __attribute__((ext_vector_type(4)));
constexpr int BM = 256, BK = 64, HALF = 128, HTB = HALF * BK * 2  , STAGE_BYTES = 8 * HTB, NXCD = 8, WGM = 8;

__host__ __device__ __forceinline__ int lds_byte(int r, int c) { const int st = (r >> 4) * 2 + (c >> 5), rr = r & 15, cc = c & 31, ob = rr * 64 + cc * 2; return st * 1024 + (ob ^ (((ob >> 9) & 1) << 5)); }
__host__ __device__ __forceinline__ void stage_rc(int b, int& R, int& C) { const int st = b / 1024, sb = b % 1024, swz = sb ^ (((sb >> 9) & 1) << 5); R = (st >> 1) * 16 + swz / 64; C = (st & 1) * 32 + (swz % 64) / 2; }
__host__ __device__ __forceinline__ int perm32(int rho) { const int n = rho >> 4, i = rho & 15; return 8 * (i >> 2) + 4 * n + (i & 3); }

struct Unit { int pm, pn; };
struct Gemm { const bf16_t* A; const bf16_t* Bt; int M, N, K; };

struct StaticOrder {
    int nM, nN, nwg, G, c;
    __host__ __device__ void init(int M, int N, int G_, int c_) { nM = M / BM; nN = N / BM; nwg = nM * nN; G = G_; c = c_; }
    __host__ __device__ bool next(int i, Unit& u) const {
        const long L = (long)i * G + c; if (L >= nwg) return false;
        int wgid = (int)L; { const int q = nwg / NXCD, r = nwg % NXCD, xcd = wgid % NXCD, off = wgid / NXCD; wgid = (xcd < r ? xcd * (q + 1) : r * (q + 1) + (xcd - r) * q) + off; }
        const int nig = WGM * nN, gid = wgid / nig, fm = gid * WGM, gsz = (nM - fm) < WGM ? (nM - fm) : WGM;
        u.pm = fm + ((wgid % nig) % gsz); u.pn = (wgid % nig) / gsz; return true;
    }
    __device__ __forceinline__ void a_ready(const Unit&) const {}
    __device__ __forceinline__ void done(const Unit&) const {}
};

__device__ __forceinline__ unsigned cvt_pk_bf16(float lo, float hi) { unsigned r; asm volatile("v_cvt_pk_bf16_f32 %0, %1, %2" : "=v"(r) : "v"(lo), "v"(hi)); return r; }
template <class Epi, class Sched, bool ALIGN_EPI = false, bool SP2 = false>
__device__ __forceinline__ void gemm_phase(PG8_LAS unsigned char* lds, const Gemm g, const Sched& S, const Epi& E) {
    const int tid = threadIdx.x, wid = __builtin_amdgcn_readfirstlane(tid >> 6), lane = tid & 63, wr = wid >> 2, wc = wid & 3, fr = lane & 15, fq = lane >> 4;
    const int K = g.K, nt = K / BK;
    unsigned voffA[2], voffB[2];
#pragma unroll
    for (int i = 0; i < 2; ++i) { int R, C; stage_rc(tid * 16 + i * 8192, R, C); const int Rb = Epi::PERM ? ((R & ~31) + perm32(R & 31)) : R;
        voffA[i] = (unsigned)(R * K + C) * 2u; voffB[i] = (unsigned)(Rb * K + C) * 2u; }
    const size_t kstep = (size_t)(BK * 2);
    const size_t hstep = (size_t)HALF * K * 2;
    const size_t tstep = 2 * hstep;
    const unsigned ldsw = (unsigned)wid * 1024u;
    const int aoff = lds_byte(wr * 64 + fr, fq * 8), boff = lds_byte(wc * 32 + fr, fq * 8);
#define PG8_SA(b, h) (((b) * 2 + (h)) * HTB)
#define PG8_SB(b, h) ((4 + (b) * 2 + (h)) * HTB)
#define PG8_STAGE(bufoff, gbase, voff) do { _Pragma("unroll") for (int _i = 0; _i < 2; ++_i) \
        __builtin_amdgcn_global_load_lds((const unsigned*)((const char*)(gbase) + (voff)[_i]), (PG8_LAS unsigned*)(lds + (bufoff) + ldsw + _i * 8192), 16, 0, 0); } while (0)
#define PG8_LDA(dst, b, h) do { _Pragma("unroll") for (int m = 0; m < 4; ++m) _Pragma("unroll") for (int k = 0; k < 2; ++k) dst[m][k] = *(const PG8_LAS bf16x8*)(lds + PG8_SA(b, h) + aoff + m * 2048 + k * 1024); } while (0)
#define PG8_LDB(dst, b, h) do { _Pragma("unroll") for (int n = 0; n < 2; ++n) _Pragma("unroll") for (int k = 0; k < 2; ++k) dst[n][k] = *(const PG8_LAS bf16x8*)(lds + PG8_SB(b, h) + boff + n * 2048 + k * 1024); } while (0)
#define PG8_MMA(ai, bj, At, Bt) do { __builtin_amdgcn_s_setprio(1); _Pragma("unroll") for (int m = 0; m < 4; ++m) _Pragma("unroll") for (int n = 0; n < 2; ++n) _Pragma("unroll") for (int k = 0; k < 2; ++k) \
        acc[ai][bj][m][n] = __builtin_amdgcn_mfma_f32_16x16x32_bf16(Bt[n][k], At[m][k], acc[ai][bj][m][n], 0, 0, 0); __builtin_amdgcn_s_setprio(0); } while (0)
#define PG8_WAIT_V(n) asm volatile("s_waitcnt vmcnt(" #n ")" ::: "memory")
#define PG8_WAIT_L(n) asm volatile("s_waitcnt lgkmcnt(" #n ")" ::: "memory")
#define PG8_BAR __builtin_amdgcn_s_barrier()
#define PG8_SCHED __builtin_amdgcn_sched_barrier(0)
    Unit cur, nxt; int ui = 0;
    if (!S.next(0, cur)) return;
    f32x4 acc[2][2][4][2];
#pragma unroll
    for (int a = 0; a < 2; ++a)
#pragma unroll
        for (int b = 0; b < 2; ++b)
#pragma unroll
            for (int m = 0; m < 4; ++m)
#pragma unroll
                for (int n = 0; n < 2; ++n) acc[a][b][m][n] = (f32x4){0.f, 0.f, 0.f, 0.f};
    bf16x8 At[4][2], B0[2][2], B1[2][2];
    const char* cA = (const char*)g.A + (size_t)cur.pm * tstep; const char* cB = (const char*)g.Bt + (size_t)cur.pn * tstep;
    S.a_ready(cur);
    if constexpr (SP2) {
        PG8_STAGE(PG8_SB(0, 0), cB, voffB); PG8_STAGE(PG8_SB(0, 1), cB + hstep, voffB); PG8_STAGE(PG8_SA(0, 0), cA, voffA); PG8_STAGE(PG8_SA(0, 1), cA + hstep, voffA);
        if (wr == 1) PG8_BAR;
        PG8_WAIT_V(2); PG8_BAR;
        PG8_STAGE(PG8_SB(1, 0), cB + kstep, voffB); PG8_STAGE(PG8_SA(1, 0), cA + kstep, voffA); PG8_STAGE(PG8_SB(1, 1), cB + hstep + kstep, voffB);
        PG8_WAIT_V(6); PG8_BAR;
    } else {
        PG8_STAGE(PG8_SB(0, 0), cB, voffB); PG8_STAGE(PG8_SA(0, 0), cA, voffA); PG8_STAGE(PG8_SB(0, 1), cB + hstep, voffB); PG8_STAGE(PG8_SA(0, 1), cA + hstep, voffA);
        if (wr == 1) PG8_BAR;
        PG8_WAIT_V(4); PG8_BAR;
        PG8_STAGE(PG8_SB(1, 0), cB + kstep, voffB); PG8_STAGE(PG8_SA(1, 0), cA + kstep, voffA); PG8_STAGE(PG8_SB(1, 1), cB + hstep + kstep, voffB);
        PG8_WAIT_V(6); PG8_BAR;
    }
    for (;;) {
        const bool has_next = S.next(ui + 1, nxt);
        const char* nA = has_next ? (const char*)g.A + (size_t)nxt.pm * tstep : cA; const char* nB = has_next ? (const char*)g.Bt + (size_t)nxt.pn * tstep : cB;
        for (int t = 0; t < nt; t += 2) {
            const bool last = (t == nt - 2);
            const char* a1 = cA + (size_t)(t + 1) * kstep;
            const char* a2 = last ? nA : cA + (size_t)(t + 2) * kstep; const char* b2 = last ? nB : cB + (size_t)(t + 2) * kstep;
            const char* a3 = a2 + kstep; const char* b3 = b2 + kstep;
            if (last && has_next) S.a_ready(nxt);
            if constexpr (SP2) {
            PG8_LDB(B0, 0, 0); PG8_LDB(B1, 0, 1); PG8_SCHED; PG8_LDA(At, 0, 0); PG8_STAGE(PG8_SA(1, 1), a1 + hstep, voffA);
            PG8_WAIT_V(8); PG8_WAIT_L(0); PG8_BAR; PG8_MMA(0, 0, At, B0); PG8_MMA(0, 1, At, B1); PG8_BAR; PG8_SCHED;
            PG8_LDA(At, 0, 1); PG8_STAGE(PG8_SB(0, 0), b2, voffB); PG8_STAGE(PG8_SB(0, 1), b2 + hstep, voffB); PG8_STAGE(PG8_SA(0, 0), a2, voffA);
            PG8_WAIT_V(8); PG8_WAIT_L(0); PG8_BAR; PG8_MMA(1, 0, At, B0); PG8_MMA(1, 1, At, B1); PG8_BAR; PG8_SCHED;
            PG8_LDB(B0, 1, 0); PG8_LDB(B1, 1, 1); PG8_SCHED; PG8_LDA(At, 1, 0); PG8_STAGE(PG8_SA(0, 1), a2 + hstep, voffA);
            PG8_WAIT_V(8); PG8_WAIT_L(0); PG8_BAR; PG8_MMA(0, 0, At, B0); PG8_MMA(0, 1, At, B1); PG8_BAR; PG8_SCHED;
            PG8_LDA(At, 1, 1); PG8_STAGE(PG8_SB(1, 0), b3, voffB); PG8_STAGE(PG8_SB(1, 1), b3 + hstep, voffB); PG8_STAGE(PG8_SA(1, 0), a3, voffA);
            PG8_WAIT_V(8); PG8_WAIT_L(0); PG8_BAR; PG8_MMA(1, 0, At, B0); PG8_MMA(1, 1, At, B1); PG8_BAR; PG8_SCHED;
            } else {
            PG8_LDB(B0, 0, 0); PG8_SCHED; PG8_LDA(At, 0, 0); PG8_STAGE(PG8_SA(1, 1), a1 + hstep, voffA);
            PG8_WAIT_L(8); PG8_BAR; PG8_WAIT_L(0); PG8_MMA(0, 0, At, B0); PG8_BAR; PG8_SCHED;
            PG8_LDB(B1, 0, 1); PG8_STAGE(PG8_SB(0, 0), b2, voffB);
            PG8_BAR; PG8_WAIT_L(0); PG8_MMA(0, 1, At, B1); PG8_BAR;
            PG8_LDA(At, 0, 1); PG8_STAGE(PG8_SA(0, 0), a2, voffA);
            PG8_BAR; PG8_WAIT_L(0); PG8_MMA(1, 0, At, B0); PG8_BAR; PG8_SCHED;
            PG8_STAGE(PG8_SB(0, 1), b2 + hstep, voffB);
            PG8_WAIT_V(6); PG8_BAR; PG8_MMA(1, 1, At, B1); PG8_BAR;
            PG8_LDB(B0, 1, 0); PG8_SCHED; PG8_LDA(At, 1, 0); PG8_STAGE(PG8_SA(0, 1), a2 + hstep, voffA);
            PG8_WAIT_L(8); PG8_BAR; PG8_WAIT_L(0); PG8_MMA(0, 0, At, B0); PG8_BAR; PG8_SCHED;
            PG8_LDB(B1, 1, 1); PG8_STAGE(PG8_SB(1, 0), b3, voffB);
            PG8_BAR; PG8_WAIT_L(0); PG8_MMA(0, 1, At, B1); PG8_BAR;
            PG8_LDA(At, 1, 1); PG8_STAGE(PG8_SA(1, 0), a3, voffA);
            PG8_BAR; PG8_WAIT_L(0); PG8_MMA(1, 0, At, B0); PG8_BAR; PG8_SCHED;
            PG8_STAGE(PG8_SB(1, 1), b3 + hstep, voffB);
            PG8_WAIT_V(6); PG8_BAR; PG8_MMA(1, 1, At, B1); PG8_BAR;
            }
        }
        if constexpr (ALIGN_EPI) { if (wr == 0) PG8_BAR; }
        if constexpr (!Epi::AFTER_DRAIN) { E(acc, cur, wr, wc, fr, fq); S.done(cur); }
        if (!has_next) break;
#pragma unroll
        for (int a = 0; a < 2; ++a)
#pragma unroll
            for (int b = 0; b < 2; ++b)
#pragma unroll
                for (int m = 0; m < 4; ++m)
#pragma unroll
                    for (int n = 0; n < 2; ++n) acc[a][b][m][n] = (f32x4){0.f, 0.f, 0.f, 0.f};
        cur = nxt; cA = nA; cB = nB; ++ui;
        if constexpr (ALIGN_EPI) { if (wr == 1) PG8_BAR; }
    }
    PG8_WAIT_V(0);
    if constexpr (!ALIGN_EPI) { if (wr == 0) PG8_BAR; }
    PG8_BAR;
    if constexpr (Epi::AFTER_DRAIN) { E.fused(acc, cur, wr, wc, fr, fq, lds, wid, lane); S.done(cur); }
#undef PG8_SA
#undef PG8_SB
#undef PG8_STAGE
#undef PG8_LDA
#undef PG8_LDB
#undef PG8_MMA
#undef PG8_WAIT_V
#undef PG8_WAIT_L
#undef PG8_BAR
#undef PG8_SCHED
}
}

constexpr int BATCH = 32, SEQ = 2048, DM = 1024, MTOK = BATCH * SEQ, NQKV = 3072, FF = 2816, NGU = 2 * FF, INC = 3080;
constexpr float EPS = 1e-6f, LOG2E = 1.4426950408889634f, QSCALE = 0.125f * LOG2E;
constexpr int NTHREADS = 512, NWAVES = 8;
constexpr int LDS_BYTES = 131072 + 256 + 4096 + 256;
constexpr size_t MiB = 1u << 20;
constexpr size_t WS_GTAB = 25 * MiB + 512 * 1024, WS_CTL = 25 * MiB + 768 * 1024, CTL_BYTES = 16384;
constexpr size_t WS_WQKV = 0, WS_WO = 6 * MiB, WS_WGU = 8 * MiB, WS_WD = 19 * MiB, WS_ROPE = 25 * MiB, WS_LOGF = 26 * MiB, WS_C2 = 28 * MiB, WS_SSQ = 30 * MiB, WS_LSE = 34 * MiB;
constexpr size_t WS_QKV = 40 * MiB, WS_XN = 432 * MiB, WS_OF = 560 * MiB, WS_OD = 624 * MiB, WS_ON = WS_XN, WS_X1B = WS_QKV, WS_H = 168 * MiB, WS_END = 816 * MiB;
constexpr size_t OD_STRIDE = (size_t)MTOK * 512;
constexpr size_t HSTRIDE = (size_t)SEQ * 64 + 2048, SECS = (size_t)256 * HSTRIDE;

#define LAS __attribute__((address_space(3)))
typedef pg8::bf16_t bf16_t;
typedef pg8::f32x4 f32x4;
typedef pg8::u32x4 u32x4;
typedef unsigned u32x2 __attribute__((ext_vector_type(2)));
using pg8::cvt_pk_bf16;
__device__ __forceinline__ float bf2f(unsigned short v) { return __uint_as_float((unsigned)v << 16); }
__device__ __forceinline__ float wave_sum(float v) {
#pragma unroll
    for (int o = 1; o < 64; o <<= 1) v += __shfl_xor(v, o);
    return v;
}

__device__ __forceinline__ float xsum16(float x) { auto r = __builtin_amdgcn_permlane16_swap(__float_as_uint(x), __float_as_uint(x), false, false); return __uint_as_float(r[0]) + __uint_as_float(r[1]); }
__device__ __forceinline__ float xsum32(float x) { auto r = __builtin_amdgcn_permlane32_swap(__float_as_uint(x), __float_as_uint(x), false, false); return __uint_as_float(r[0]) + __uint_as_float(r[1]); }

struct Args {
    const float* x; const float* g_mix; const float* w_in; const float* b_forget; const float* g_q_fox; const float* g_k_fox; const float* g_q_dil; const float* g_k_dil;
    const float* g_out_fox; const float* g_out_dil; const float* w_out; const float* g_ffn; const float* w_gate; const float* w_up; const float* w_down;
    float* out; unsigned char* ws; int ph_lo, ph_hi;
};

struct EpiQKV {
    static constexpr bool PERM = true, AFTER_DRAIN = false;
    bf16_t* O; const float* gtab; const float* rope;
    __device__ __forceinline__ void operator()(const f32x4 (&acc)[2][2][4][2], const pg8::Unit& u, int wr, int wc, int fr, int fq) const {
        const int sec = u.pn >> 1;
        const bool isv = (sec == 2) || (sec == 5), isq = (sec == 0) || (sec == 3), dil = sec >= 3;
        const float* g = gtab + sec * 64;
        const size_t hbase = ((size_t)sec * 256 + (u.pn & 1) * 4 + wc) * HSTRIDE + fq * 8;
        const float qs = isq ? QSCALE : 1.f;
        f32x4 gv[2][2];
#pragma unroll
        for (int bj = 0; bj < 2; ++bj)
#pragma unroll
            for (int n = 0; n < 2; ++n) gv[bj][n] = *(const f32x4*)(g + bj * 32 + fq * 8 + n * 4) * qs;
        const bool rotu = dil && !isv;
        const bool rot = rotu && fq < 2;
        const float sgn = (fq == 0) ? -1.f : 1.f;
#pragma unroll
        for (int ai = 0; ai < 2; ++ai) {
            f32x4 cs[4][2][2];
            if (rot) {
#pragma unroll
                for (int m = 0; m < 4; ++m) { const float* rp = rope + (size_t)((u.pm * 256 + ai * 128 + wr * 64 + m * 16 + fr) & (SEQ - 1)) * 16;
#pragma unroll
                    for (int n = 0; n < 2; ++n) { cs[m][n][0] = *(const f32x4*)(rp + n * 8); cs[m][n][1] = *(const f32x4*)(rp + n * 8 + 4); } }
            }
#pragma unroll
            for (int m = 0; m < 4; ++m) {
                const int row = u.pm * 256 + ai * 128 + wr * 64 + m * 16 + fr;
                f32x4 v[2][2];
#pragma unroll
                for (int bj = 0; bj < 2; ++bj)
#pragma unroll
                    for (int n = 0; n < 2; ++n) v[bj][n] = acc[ai][bj][m][n];
                if (!isv) {
                    float ss = 0.f;
#pragma unroll
                    for (int bj = 0; bj < 2; ++bj)
#pragma unroll
                        for (int n = 0; n < 2; ++n) ss += (v[bj][n][0] * v[bj][n][0] + v[bj][n][1] * v[bj][n][1]) + (v[bj][n][2] * v[bj][n][2] + v[bj][n][3] * v[bj][n][3]);
                    ss = xsum32(xsum16(ss));
                    const float rs = __builtin_amdgcn_rsqf(ss * (1.f / 64.f) + EPS);
#pragma unroll
                    for (int bj = 0; bj < 2; ++bj)
#pragma unroll
                        for (int n = 0; n < 2; ++n) v[bj][n] = v[bj][n] * rs * gv[bj][n];
                    if (rotu) {
#pragma unroll
                        for (int n = 0; n < 2; ++n) {
                            f32x4 pr;
#pragma unroll
                            for (int e = 0; e < 4; ++e) { auto r = __builtin_amdgcn_permlane16_swap(__float_as_uint(v[0][n][e]), __float_as_uint(v[0][n][e]), false, false);
                                pr[e] = __uint_as_float((fq & 1) ? r[0] : r[1]); }
                            if (rot) {
                                const f32x4 cs0 = cs[m][n][0], cs1 = cs[m][n][1];
                                const f32x4 x = v[0][n];
                                v[0][n] = (f32x4){x[0] * cs0[0] + sgn * pr[0] * cs0[1], x[1] * cs0[2] + sgn * pr[1] * cs0[3], x[2] * cs1[0] + sgn * pr[2] * cs1[1], x[3] * cs1[2] + sgn * pr[3] * cs1[3]};
                            }
                        }
                    }
                }
                bf16_t* rowp = O + hbase + (size_t)(row >> 11) * 8 * HSTRIDE + (size_t)(row & (SEQ - 1)) * 64;
#pragma unroll
                for (int bj = 0; bj < 2; ++bj) {
                    u32x4 w; w.x = cvt_pk_bf16(v[bj][0][0], v[bj][0][1]); w.y = cvt_pk_bf16(v[bj][0][2], v[bj][0][3]); w.z = cvt_pk_bf16(v[bj][1][0], v[bj][1][1]); w.w = cvt_pk_bf16(v[bj][1][2], v[bj][1][3]);
                    *(u32x4*)(rowp + bj * 32) = w;
                }
            }
        }
    }
};
struct EpiOut {
    static constexpr bool PERM = false, AFTER_DRAIN = false;
    const float* x; bf16_t* x1b; float* ssq;
    __device__ __forceinline__ void operator()(const f32x4 (&acc)[2][2][4][2], const pg8::Unit& u, int wr, int wc, int fr, int fq) const {
        const int col0 = u.pn * 256 + wc * 32 + 4 * fq;
#pragma unroll
        for (int ai = 0; ai < 2; ++ai) {
            f32x4 xr[4][2][2];
#pragma unroll
            for (int m = 0; m < 4; ++m)
#pragma unroll
                for (int bj = 0; bj < 2; ++bj)
#pragma unroll
                    for (int n = 0; n < 2; ++n) xr[m][bj][n] = *(const f32x4*)(x + (size_t)(u.pm * 256 + ai * 128 + wr * 64 + m * 16 + fr) * DM + col0 + bj * 128 + n * 16);
            __builtin_amdgcn_sched_barrier(0);
#pragma unroll
            for (int m = 0; m < 4; ++m) {
                const int row = u.pm * 256 + ai * 128 + wr * 64 + m * 16 + fr;
                float ss = 0.f;
#pragma unroll
                for (int bj = 0; bj < 2; ++bj)
#pragma unroll
                    for (int n = 0; n < 2; ++n) {
                        const size_t off = (size_t)row * DM + col0 + bj * 128 + n * 16;
                        const f32x4 o = xr[m][bj][n] + acc[ai][bj][m][n];
                        ss += (o[0] * o[0] + o[1] * o[1]) + (o[2] * o[2] + o[3] * o[3]);
                        u32x2 w; w.x = cvt_pk_bf16(o[0], o[1]); w.y = cvt_pk_bf16(o[2], o[3]);
                        *(u32x2*)(x1b + off) = w;
                    }
                ss = xsum32(xsum16(ss));
                if (fq == 0) ssq[(size_t)(u.pn * 4 + wc) * MTOK + row] = ss;
            }
        }
    }
};
struct EpiGU {
    static constexpr bool PERM = true, AFTER_DRAIN = false;
    bf16_t* H; const float* ssq; LAS float* rtab; mutable int last_pm;
    __device__ __forceinline__ void operator()(const f32x4 (&acc)[2][2][4][2], const pg8::Unit& u, int wr, int wc, int fr, int fq) const {
        const int col0 = u.pn * 128 + wc * 32 + 8 * fq;
        LAS float* rt = rtab + wc * 256 + wr * 64 + fr;
        if (u.pm != last_pm) {
            last_pm = u.pm;
            float pp[2][4];
#pragma unroll
            for (int ai = 0; ai < 2; ++ai)
#pragma unroll
                for (int m = 0; m < 4; ++m) { const int row = u.pm * 256 + ai * 128 + wr * 64 + m * 16 + fr; float p = 0.f;
#pragma unroll
                    for (int j = 0; j < 4; ++j) p += ssq[(size_t)(fq * 4 + j) * MTOK + row];
                    pp[ai][m] = p; }
#pragma unroll
            for (int ai = 0; ai < 2; ++ai)
#pragma unroll
                for (int m = 0; m < 4; ++m) { const float p = xsum32(xsum16(pp[ai][m])); if (fq == 0) rt[ai * 128 + m * 16] = __builtin_amdgcn_rsqf(p * (1.f / DM) + EPS); }
        }
#pragma unroll
        for (int ai = 0; ai < 2; ++ai)
#pragma unroll
            for (int m = 0; m < 4; ++m) {
                const int row = u.pm * 256 + ai * 128 + wr * 64 + m * 16 + fr;
                const float rs = rt[ai * 128 + m * 16];
                typedef float f32x2 __attribute__((ext_vector_type(2)));
                const float kneg = -rs * LOG2E, rs2 = rs * rs;
                float hv[8];
#pragma unroll
                for (int n = 0; n < 2; ++n)
#pragma unroll
                    for (int e2 = 0; e2 < 2; ++e2) {
                        const f32x2 gg = {acc[ai][0][m][n][2 * e2], acc[ai][0][m][n][2 * e2 + 1]}, uu = {acc[ai][1][m][n][2 * e2], acc[ai][1][m][n][2 * e2 + 1]};
                        const f32x2 t = gg * kneg, pq = (gg * uu) * rs2;
                        f32x2 d; d.x = __builtin_amdgcn_exp2f(t.x); d.y = __builtin_amdgcn_exp2f(t.y);
                        d = d + 1.0f;
                        f32x2 r; r.x = __builtin_amdgcn_rcpf(d.x); r.y = __builtin_amdgcn_rcpf(d.y);
                        const f32x2 o = pq * r;
                        hv[n * 4 + 2 * e2] = o.x; hv[n * 4 + 2 * e2 + 1] = o.y;
                    }
                u32x4 w; w.x = cvt_pk_bf16(hv[0], hv[1]); w.y = cvt_pk_bf16(hv[2], hv[3]); w.z = cvt_pk_bf16(hv[4], hv[5]); w.w = cvt_pk_bf16(hv[6], hv[7]);
                *(u32x4*)(H + (size_t)row * FF + col0) = w;
            }
    }
};
struct EpiDown {
    static constexpr bool PERM = false, AFTER_DRAIN = false;
    float* out; const bf16_t* x1b;
    __device__ __forceinline__ void operator()(const f32x4 (&acc)[2][2][4][2], const pg8::Unit& u, int wr, int wc, int fr, int fq) const {
        const int col0 = u.pn * 256 + wc * 32 + 4 * fq;
        u32x2 xw[2][4][2][2];
#pragma unroll
        for (int ai = 0; ai < 2; ++ai)
#pragma unroll
            for (int m = 0; m < 4; ++m)
#pragma unroll
                for (int bj = 0; bj < 2; ++bj)
#pragma unroll
                    for (int n = 0; n < 2; ++n) xw[ai][m][bj][n] = *(const u32x2*)(x1b + (size_t)(u.pm * 256 + ai * 128 + wr * 64 + m * 16 + fr) * DM + col0 + bj * 128 + n * 16);
        __builtin_amdgcn_sched_barrier(0);
#pragma unroll
        for (int ai = 0; ai < 2; ++ai)
#pragma unroll
            for (int m = 0; m < 4; ++m) {
                const int row = u.pm * 256 + ai * 128 + wr * 64 + m * 16 + fr;
#pragma unroll
                for (int bj = 0; bj < 2; ++bj)
#pragma unroll
                    for (int n = 0; n < 2; ++n) {
                        const size_t off = (size_t)row * DM + col0 + bj * 128 + n * 16;
                        const u32x2 w = xw[ai][m][bj][n];
                        const f32x4 xr = {__uint_as_float(w.x << 16), __uint_as_float(w.x & 0xffff0000u), __uint_as_float(w.y << 16), __uint_as_float(w.y & 0xffff0000u)};
                        *(f32x4*)(out + off) = xr + acc[ai][bj][m][n];
                    }
            }
    }
};
template <int WHICH> __device__ __forceinline__ void tr_item(const float* W, const float* W2, const float* gk, bf16_t* WT, int K, int Nsrc, int Nd, LAS float* scr, int item, int lane) {
    const int nblk = Nd / 32, kb = item / nblk, nb = item % nblk, k0 = 64 * kb, c0 = 32 * nb;
    const int c = c0 + (lane & 31);
    int sc; const float* src = W;
    if (WHICH == 0) { const int pn = c >> 8, cp = c & 255; const int bc = pn * 256 + ((cp >> 5) & 3) * 64 + (cp >> 7) * 32 + ((cp >> 3) & 3) * 8 + (cp & 7); sc = bc < 1536 ? bc : bc + 8; }
    else if (WHICH == 2) { const int pn = c >> 8, cp = c & 255; sc = pn * 128 + (cp & 127); src = (cp >> 7) ? W2 : W; }
    else sc = c;
#pragma unroll 8
    for (int i = 0; i < 32; ++i) { const int kk = 2 * i + (lane >> 5); float v = __builtin_nontemporal_load(src + (size_t)(k0 + kk) * Nsrc + sc); if (gk) v *= gk[k0 + kk]; scr[kk * 33 + (lane & 31)] = v; }
    asm volatile("s_waitcnt lgkmcnt(0)" ::: "memory");
    const int c8 = lane & 7;
#pragma unroll
    for (int j = 0; j < 4; ++j) { const int n = (lane >> 3) + 8 * j; const LAS float* s = scr + (8 * c8) * 33 + n;
        u32x4 o; o.x = cvt_pk_bf16(s[0 * 33], s[1 * 33]); o.y = cvt_pk_bf16(s[2 * 33], s[3 * 33]); o.z = cvt_pk_bf16(s[4 * 33], s[5 * 33]); o.w = cvt_pk_bf16(s[6 * 33], s[7 * 33]);
        *(u32x4*)(WT + (size_t)(c0 + n) * K + k0 + 8 * c8) = o; }
    asm volatile("s_waitcnt lgkmcnt(0)" ::: "memory");
}
__device__ __forceinline__ void p0_prologue(const Args& A, LAS unsigned char* lds, int vcu, int G, int wave, int lane) {
    unsigned char* ws = A.ws;
    LAS float* scr = (LAS float*)(lds + wave * 16384);
    const int gw = vcu * NWAVES + wave, NGW = G * NWAVES;
    constexpr int I_QKV = (DM / 64) * (NQKV / 32), I_O = (DM / 64) * (DM / 32), I_GU = (DM / 64) * (NGU / 32), I_D = (FF / 64) * (DM / 32), NITEMS = I_QKV + I_O + I_GU + I_D;
    for (int it = gw; it < NITEMS; it += NGW) {
        int r = it;
        if (r < I_QKV) { tr_item<0>(A.w_in, nullptr, nullptr, (bf16_t*)(ws + WS_WQKV), DM, INC, NQKV, scr, r, lane); continue; } r -= I_QKV;
        if (r < I_O) { tr_item<1>(A.w_out, nullptr, nullptr, (bf16_t*)(ws + WS_WO), DM, DM, DM, scr, r, lane); continue; } r -= I_O;
        if (r < I_GU) { tr_item<2>(A.w_gate, A.w_up, A.g_ffn, (bf16_t*)(ws + WS_WGU), DM, FF, NGU, scr, r, lane); continue; } r -= I_GU;
        tr_item<1>(A.w_down, nullptr, nullptr, (bf16_t*)(ws + WS_WD), FF, DM, DM, scr, r, lane);
    }
    {
        const float invf[8] = {1.0f, 0.1939227432012558f, 0.03760603070259094f, 0.007292664609849453f, 0.0014142135623842478f, 0.00027424818836152554f, 5.318296098266728e-05f, 1.0313386155758053e-05f};
        float* rope = (float*)(ws + WS_ROPE);
        for (int idx = gw * 64 + lane; idx < SEQ * 8; idx += NGW * 64) {
            const int pos = idx >> 3, i = idx & 7;
            float fr_ = invf[0];
#pragma unroll
            for (int j = 1; j < 8; ++j) fr_ = (i == j) ? invf[j] : fr_;
            const float angf = (float)pos * fr_;
            const double a = (double)angf, kq = rint(a * 0.63661977236758134308);
            double r = fma(-kq, 1.5707963267948966, a); r = fma(-kq, 6.123233995736766e-17, r);
            const int q = (int)((long long)kq & 3);
            const double r2 = r * r;
            const double sr = r * (1.0 + r2 * (-1.0 / 6 + r2 * (1.0 / 120 + r2 * (-1.0 / 5040 + r2 * (1.0 / 362880 + r2 * (-1.0 / 39916800 + r2 * (1.0 / 6227020800.0)))))));
            const double cr = 1.0 + r2 * (-0.5 + r2 * (1.0 / 24 + r2 * (-1.0 / 720 + r2 * (1.0 / 40320 + r2 * (-1.0 / 3628800 + r2 * (1.0 / 479001600.0))))));
            const double s = (q == 0) ? sr : (q == 1) ? cr : (q == 2) ? -sr : -cr;
            const double c = (q == 0) ? cr : (q == 1) ? -sr : (q == 2) ? -cr : sr;
            rope[idx * 2] = (float)c; rope[idx * 2 + 1] = (float)s;
        }
    }
    if (gw == 0) { float* gt = (float*)(ws + WS_GTAB);
        gt[lane] = A.g_q_fox[lane]; gt[64 + lane] = A.g_k_fox[lane]; gt[128 + lane] = 1.f; gt[192 + lane] = A.g_q_dil[lane]; gt[256 + lane] = A.g_k_dil[lane]; gt[320 + lane] = 1.f; }
    f32x4 gm[4]; f32x4 wf[4][4][2];
#pragma unroll
    for (int j = 0; j < 4; ++j) { gm[j] = *(const f32x4*)(A.g_mix + 256 * j + 4 * lane);
#pragma unroll
        for (int e = 0; e < 4; ++e) { const float* wp = A.w_in + (size_t)(256 * j + 4 * lane + e) * INC + 1536; wf[j][e][0] = *(const f32x4*)wp * gm[j][e]; wf[j][e][1] = *(const f32x4*)(wp + 4) * gm[j][e]; } }
    const int hmine = ((lane >> 5) & 1) * 4 + ((lane >> 4) & 1) * 2 + ((lane >> 3) & 1);
    const float bfg = A.b_forget[hmine];
    bf16_t* XN = (bf16_t*)(ws + WS_XN); float* logf_ = (float*)(ws + WS_LOGF);
#define P0_LOAD(V, M_) do { _Pragma("unroll") for (int j = 0; j < 4; ++j) V[j] = __builtin_nontemporal_load((const f32x4*)(A.x + (size_t)(M_) * DM) + lane + 64 * j); } while (0)
#define P0_ROW(V, M_) do { \
        f32x4 v[4]; float ss = 0.f; \
        _Pragma("unroll") for (int j = 0; j < 4; ++j) v[j] = V[j]; \
        if ((M_) + 2 * NGW < MTOK) P0_LOAD(V, (M_) + 2 * NGW); \
        _Pragma("unroll") for (int j = 0; j < 4; ++j) ss += (v[j][0] * v[j][0] + v[j][1] * v[j][1]) + (v[j][2] * v[j][2] + v[j][3] * v[j][3]); \
        const float rstd = 1.f / sqrtf(wave_sum(ss) * (1.f / DM) + EPS); \
        unsigned long long* o8 = (unsigned long long*)(XN + (size_t)(M_) * DM) + lane; \
        f32x4 f0 = {0.f, 0.f, 0.f, 0.f}, f1 = {0.f, 0.f, 0.f, 0.f}; \
        _Pragma("unroll") for (int j = 0; j < 4; ++j) { \
            const f32x4 hn = v[j] * rstd * gm[j]; \
            o8[64 * j] = (unsigned long long)cvt_pk_bf16(hn[0], hn[1]) | ((unsigned long long)cvt_pk_bf16(hn[2], hn[3]) << 32); \
            _Pragma("unroll") for (int e = 0; e < 4; ++e) { f0 += wf[j][e][0] * v[j][e]; f1 += wf[j][e][1] * v[j][e]; } } \
        f32x4 k4; \
        _Pragma("unroll") for (int e = 0; e < 4; ++e) { const float send = b5 ? f0[e] : f1[e], keep = b5 ? f1[e] : f0[e]; k4[e] = keep + __shfl_xor(send, 32); } \
        float k2[2]; \
        _Pragma("unroll") for (int e = 0; e < 2; ++e) { const float send = b4 ? k4[e] : k4[2 + e], keep = b4 ? k4[2 + e] : k4[e]; k2[e] = keep + __shfl_xor(send, 16); } \
        float k1; \
        { const float send = b3 ? k2[0] : k2[1], keep = b3 ? k2[1] : k2[0]; k1 = keep + __shfl_xor(send, 8); } \
        k1 += __shfl_xor(k1, 4); k1 += __shfl_xor(k1, 2); k1 += __shfl_xor(k1, 1); \
        const float z = k1 * rstd + bfg; \
        const float lf = (z >= 0.f) ? -log1pf(__expf(-z)) : z - log1pf(__expf(z)); \
        if ((lane & 7) == 0) logf_[(size_t)(M_) * 8 + hmine] = lf; } while (0)
    const bool b5 = (lane & 32) != 0, b4 = (lane & 16) != 0, b3 = (lane & 8) != 0;
    f32x4 va[4], vb[4];
    if (gw < MTOK) P0_LOAD(va, gw);
    if (gw + NGW < MTOK) P0_LOAD(vb, gw + NGW);
    for (int m = gw; m < MTOK; m += 2 * NGW) {
        P0_ROW(va, m);
        if (m + NGW < MTOK) P0_ROW(vb, m + NGW);
    }
#undef P0_ROW
#undef P0_LOAD
}
__device__ __forceinline__ void cumsum_phase(const Args& A, int vcu, int G, int wave, int lane) {
    if (wave != 0) return;
    const float* logf_ = (const float*)(A.ws + WS_LOGF); float* c2 = (float*)(A.ws + WS_C2);
    for (int seq = vcu; seq < BATCH * 8; seq += G) {
        const int b = seq >> 3, hh = seq & 7;
        float vals[32]; float run = 0.f;
#pragma unroll
        for (int i = 0; i < 32; ++i) { run += logf_[((size_t)b * SEQ + 32 * lane + i) * 8 + hh]; vals[i] = run; }
        float inc = run;
#pragma unroll
        for (int o = 1; o < 64; o <<= 1) { const float t = __shfl_up(inc, o); if (lane >= o) inc += t; }
        const float excl = inc - run;
#pragma unroll
        for (int i = 0; i < 32; ++i) c2[(size_t)seq * SEQ + 32 * lane + i] = (excl + vals[i]) * LOG2E;
    }
}
__device__ __forceinline__ void merge_phase(const Args& A, int vcu, int G, int wave, int lane) {
    const bf16_t* OF = (const bf16_t*)(A.ws + WS_OF); const bf16_t* OD = (const bf16_t*)(A.ws + WS_OD); const float* LSE = (const float*)(A.ws + WS_LSE); bf16_t* ON = (bf16_t*)(A.ws + WS_ON);
    const int gw = vcu * NWAVES + wave, NGW = G * NWAVES;
    float gf[8], gd[8];
    { const f32x4 a = *(const f32x4*)(A.g_out_fox + 8 * lane), b = *(const f32x4*)(A.g_out_fox + 8 * lane + 4), c = *(const f32x4*)(A.g_out_dil + 8 * lane), d = *(const f32x4*)(A.g_out_dil + 8 * lane + 4);
#pragma unroll
      for (int e = 0; e < 4; ++e) { gf[e] = a[e]; gf[4 + e] = b[e]; gd[e] = c[e]; gd[4 + e] = d[e]; } }
    u32x4 fwn, dwn[3]; float lsn[3];
#define MERGE_LOAD(M_) do { fwn = __builtin_nontemporal_load((const u32x4*)(OF + (size_t)(M_) * 512 + 8 * lane)); \
        _Pragma("unroll") for (int i = 0; i < 3; ++i) { dwn[i] = __builtin_nontemporal_load((const u32x4*)(OD + (size_t)i * OD_STRIDE + (size_t)(M_) * 512 + 8 * lane)); lsn[i] = LSE[((size_t)i * MTOK + (M_)) * 8 + (lane >> 3)]; } } while (0)
    if (gw < MTOK) MERGE_LOAD(gw);
    for (int m = gw; m < MTOK; m += NGW) {
        const u32x4 fw = fwn; u32x4 dwc[3]; float ls[3];
#pragma unroll
        for (int i = 0; i < 3; ++i) { dwc[i] = dwn[i]; ls[i] = lsn[i]; }
        if (m + NGW < MTOK) MERGE_LOAD(m + NGW);
        float of[8], od[8] = {0.f, 0.f, 0.f, 0.f, 0.f, 0.f, 0.f, 0.f};
#pragma unroll
        for (int e = 0; e < 4; ++e) { of[2 * e] = __uint_as_float(fw[e] << 16); of[2 * e + 1] = __uint_as_float(fw[e] & 0xffff0000u); }
        const float mx = fmaxf(ls[0], fmaxf(ls[1], ls[2]));
        float wsum = 0.f;
#pragma unroll
        for (int i = 0; i < 3; ++i) {
            const float w = __builtin_amdgcn_exp2f(ls[i] - mx); wsum += w;
            const u32x4 dw = dwc[i];
#pragma unroll
            for (int e = 0; e < 4; ++e) { od[2 * e] += w * __uint_as_float(dw[e] << 16); od[2 * e + 1] += w * __uint_as_float(dw[e] & 0xffff0000u); }
        }
        const float iw = 1.f / wsum; float sf = 0.f, sd = 0.f;
#pragma unroll
        for (int e = 0; e < 8; ++e) { od[e] *= iw; sf += of[e] * of[e]; sd += od[e] * od[e]; }
        const float rf = 1.f / sqrtf(wave_sum(sf) * (1.f / 512.f) + EPS), rd = 1.f / sqrtf(wave_sum(sd) * (1.f / 512.f) + EPS);
        u32x4 a, b;
        a.x = cvt_pk_bf16(of[0] * rf * gf[0], of[1] * rf * gf[1]); a.y = cvt_pk_bf16(of[2] * rf * gf[2], of[3] * rf * gf[3]); a.z = cvt_pk_bf16(of[4] * rf * gf[4], of[5] * rf * gf[5]); a.w = cvt_pk_bf16(of[6] * rf * gf[6], of[7] * rf * gf[7]);
        b.x = cvt_pk_bf16(od[0] * rd * gd[0], od[1] * rd * gd[1]); b.y = cvt_pk_bf16(od[2] * rd * gd[2], od[3] * rd * gd[3]); b.z = cvt_pk_bf16(od[4] * rd * gd[4], od[5] * rd * gd[5]); b.w = cvt_pk_bf16(od[6] * rd * gd[6], od[7] * rd * gd[7]);
        *(u32x4*)(ON + (size_t)m * DM + 8 * lane) = a;
        *(u32x4*)(ON + (size_t)m * DM + 512 + 8 * lane) = b;
    }
}

namespace att {
typedef short bf16x8 __attribute__((ext_vector_type(8)));
typedef short s16x4 __attribute__((ext_vector_type(4)));
typedef float f32x16 __attribute__((ext_vector_type(16)));
typedef float f32x2_t __attribute__((ext_vector_type(2)));
typedef __bf16 bf16x2_t __attribute__((ext_vector_type(2)));
constexpr int KP = 144, TILE_B = 64 * KP, BUF_B = 2 * TILE_B + 256, DIL_V = 384 * KP;
constexpr float NEGBIG = -1e30f;
constexpr int NUNITS = 36 * 256;
__device__ __forceinline__ unsigned cvtpk(float lo, float hi) { f32x2_t v = {lo, hi}; bf16x2_t b = __builtin_convertvector(v, bf16x2_t); return __builtin_bit_cast(unsigned, b); }
__device__ __forceinline__ s16x4 vtr(const LAS unsigned char* p) { return __builtin_bit_cast(s16x4, __builtin_amdgcn_ds_read_tr16_b64_v4i16((LAS s16x4*)p)); }
#define ATT_MFMA(a, b, c) __builtin_amdgcn_mfma_f32_32x32x16_bf16((a), (b), (c), 0, 0, 0)

__device__ __forceinline__ void mask_blk(f32x16& s0, f32x16& s1, int bs, int W) {
#pragma unroll
    for (int i = 0; i < 16; ++i) { const int off = (i & 3) + 8 * (i >> 2);
        if ((unsigned)(bs - off) > (unsigned)W) s0[i] = NEGBIG;
        if ((unsigned)(bs - 32 - off) > (unsigned)W) s1[i] = NEGBIG; }
}
__device__ __forceinline__ void softmax_blk(f32x16& t0, f32x16& t1, float& m, float& l, f32x16& o0, f32x16& o1, u32x4 (&pw)[4]) {
    int im = max(__float_as_int(t0[0]), __float_as_int(t1[0]));
#pragma unroll
    for (int i = 1; i < 16; ++i) im = max(im, max(__float_as_int(t0[i]), __float_as_int(t1[i])));
    { auto rr = __builtin_amdgcn_permlane32_swap((unsigned)im, (unsigned)im, false, false); im = max((int)rr[0], (int)rr[1]); }
    if (__builtin_amdgcn_ballot_w64(im > 0x41000000) != 0ull) {
        float mx = fmaxf(t0[0], t1[0]);
#pragma unroll
        for (int i = 1; i < 16; ++i) mx = fmaxf(mx, fmaxf(t0[i], t1[i]));
        { auto rr = __builtin_amdgcn_permlane32_swap(__float_as_uint(mx), __float_as_uint(mx), false, false); mx = fmaxf(__uint_as_float(rr[0]), __uint_as_float(rr[1])); }
        const float dl = fmaxf(mx, 0.f), al = __builtin_amdgcn_exp2f(-dl);
        m += dl; l *= al;
#pragma unroll
        for (int i = 0; i < 16; ++i) { t0[i] -= dl; t1[i] -= dl; o0[i] *= al; o1[i] *= al; }
    }
    float ps = 0.f;
#pragma unroll
    for (int i = 0; i < 16; ++i) { t0[i] = __builtin_amdgcn_exp2f(t0[i]); t1[i] = __builtin_amdgcn_exp2f(t1[i]); ps += t0[i] + t1[i]; }
    l += ps;
#pragma unroll
    for (int sp = 0; sp < 2; ++sp) {
        pw[sp].x = cvtpk(t0[8 * sp], t0[8 * sp + 1]); pw[sp].y = cvtpk(t0[8 * sp + 2], t0[8 * sp + 3]); pw[sp].z = cvtpk(t0[8 * sp + 4], t0[8 * sp + 5]); pw[sp].w = cvtpk(t0[8 * sp + 6], t0[8 * sp + 7]);
        pw[2 + sp].x = cvtpk(t1[8 * sp], t1[8 * sp + 1]); pw[2 + sp].y = cvtpk(t1[8 * sp + 2], t1[8 * sp + 3]); pw[2 + sp].z = cvtpk(t1[8 * sp + 4], t1[8 * sp + 5]); pw[2 + sp].w = cvtpk(t1[8 * sp + 6], t1[8 * sp + 7]);
    }
}
__device__ __forceinline__ void store_blk(const f32x16& o0, const f32x16& o1, float m, float l, bf16_t* op, float* lp, int h) {
    float lt = l;
    { auto rr = __builtin_amdgcn_permlane32_swap(__float_as_uint(l), __float_as_uint(l), false, false); lt = __uint_as_float(rr[0]) + __uint_as_float(rr[1]); }
    const float il = 1.f / lt;
#pragma unroll
    for (int k = 0; k < 2; ++k) {
        {
            unsigned a0 = cvtpk(o0[8 * k] * il, o0[8 * k + 1] * il), a1 = cvtpk(o0[8 * k + 2] * il, o0[8 * k + 3] * il), b0 = cvtpk(o0[8 * k + 4] * il, o0[8 * k + 5] * il), b1 = cvtpk(o0[8 * k + 6] * il, o0[8 * k + 7] * il);
            auto r0 = __builtin_amdgcn_permlane32_swap(a0, b0, false, false); auto r1 = __builtin_amdgcn_permlane32_swap(a1, b1, false, false);
            u32x4 w; w.x = r0[0]; w.y = r1[0]; w.z = r0[1]; w.w = r1[1];
            *(u32x4*)(op + 16 * k + 8 * h) = w;
        }
        {
            unsigned a0 = cvtpk(o1[8 * k] * il, o1[8 * k + 1] * il), a1 = cvtpk(o1[8 * k + 2] * il, o1[8 * k + 3] * il), b0 = cvtpk(o1[8 * k + 4] * il, o1[8 * k + 5] * il), b1 = cvtpk(o1[8 * k + 6] * il, o1[8 * k + 7] * il);
            auto r0 = __builtin_amdgcn_permlane32_swap(a0, b0, false, false); auto r1 = __builtin_amdgcn_permlane32_swap(a1, b1, false, false);
            u32x4 w; w.x = r0[0]; w.y = r1[0]; w.z = r0[1]; w.w = r1[1];
            *(u32x4*)(op + 32 + 16 * k + 8 * h) = w;
        }
    }
    if (lp && h == 0) *lp = m + __builtin_amdgcn_logf(lt);
}

__device__ __forceinline__ void fox_unit(LAS unsigned char* lds, const bf16_t* __restrict__ QKV, const float* __restrict__ c2, bf16_t* __restrict__ Oout, int bh, int p0, int tid, int lane, int wave) {
    const int b = bh >> 3, hh = bh & 7, r32 = lane & 31, h = lane >> 5;
    const bf16_t* base = QKV + (size_t)bh * HSTRIDE;
    const float* cc = c2 + (size_t)bh * SEQ;
    const int wqA = p0 + 32 * wave, wqB = p0 + 32 * (15 - wave), tA = wqA >> 6, tB = wqB >> 6;
    bf16x8 qfA[4], qfB[4];
#pragma unroll
    for (int ks = 0; ks < 4; ++ks) { qfA[ks] = *(const bf16x8*)(base + (size_t)(wqA + r32) * 64 + 16 * ks + 8 * h); qfB[ks] = *(const bf16x8*)(base + (size_t)(wqB + r32) * 64 + 16 * ks + 8 * h); }
    const float cqA = cc[wqA + r32], cqB = cc[wqB + r32];
    const int n_st = (p0 + 512) >> 7;
    const int skey = tid >> 3, sch = tid & 7;
    const bf16_t* gk = base + SECS + (size_t)skey * 64 + sch * 8;
    const size_t tstep = (size_t)64 * 64;
    const int soff = skey * KP + sch * 16, coff = (tid >> 6) * BUF_B + 2 * TILE_B + (tid & 63) * 4;
    u32x4 kreg0 = *(const u32x4*)gk, vreg0 = *(const u32x4*)(gk + SECS), kreg1 = *(const u32x4*)(gk + tstep), vreg1 = *(const u32x4*)(gk + tstep + SECS); float creg = 0.f;
    if (tid < 128) creg = cc[tid];
    *(LAS u32x4*)(lds + soff) = kreg0; *(LAS u32x4*)(lds + TILE_B + soff) = vreg0; *(LAS u32x4*)(lds + BUF_B + soff) = kreg1; *(LAS u32x4*)(lds + BUF_B + TILE_B + soff) = vreg1;
    if (tid < 128) *(LAS float*)(lds + coff) = creg;
    __syncthreads();
    float mA = 0.f, lA = 0.f, mB = 0.f, lB = 0.f; f32x16 oA0, oA1, oB0, oB1;
#pragma unroll
    for (int i = 0; i < 16; ++i) { oA0[i] = 0.f; oA1[i] = 0.f; oB0[i] = 0.f; oB1[i] = 0.f; }
    const int i16 = lane & 15, vq = i16 >> 2, vp = i16 & 3, vblk = (lane >> 4) & 1;
    const int voff = (4 * h + vq) * KP + (16 * vblk + 4 * vp) * 2;
    for (int st = 0; st < n_st; ++st) {
        const int cur = st & 1; const bool more = st + 1 < n_st;
        if (more) { const bf16_t* gn = gk + (size_t)(2 * st + 2) * tstep; kreg0 = *(const u32x4*)gn; vreg0 = *(const u32x4*)(gn + SECS); kreg1 = *(const u32x4*)(gn + tstep); vreg1 = *(const u32x4*)(gn + tstep + SECS);
                    if (tid < 128) creg = cc[(st + 1) * 128 + tid]; }
#pragma unroll 1
        for (int sub = 0; sub < 2; ++sub) {
        const int tk0 = st * 128 + sub * 64, tix = 2 * st + sub;
        if (tix <= tB) {
            const bool doA = tix <= tA;
            const LAS unsigned char* kb_ = lds + (cur * 2 + sub) * BUF_B; const LAS unsigned char* vb_ = kb_ + TILE_B; const LAS float* cb_ = (const LAS float*)(kb_ + 2 * TILE_B);
            f32x16 sA0, sA1, sB0, sB1;
            { const float cmA = cqA - mA, cmB = cqB - mB;
#pragma unroll
            for (int g = 0; g < 4; ++g) { const f32x4 c0 = *(const LAS f32x4*)(cb_ + 8 * g + 4 * h), c1 = *(const LAS f32x4*)(cb_ + 32 + 8 * g + 4 * h);
#pragma unroll
                for (int e = 0; e < 4; ++e) { sA0[4 * g + e] = cmA - c0[e]; sA1[4 * g + e] = cmA - c1[e]; sB0[4 * g + e] = cmB - c0[e]; sB1[4 * g + e] = cmB - c1[e]; } } }
#pragma unroll
            for (int kh = 0; kh < 2; ++kh) { bf16x8 kf[4];
#pragma unroll
                for (int k2 = 0; k2 < 2; ++k2) { const int ks = 2 * kh + k2; kf[2 * k2] = *(const LAS bf16x8*)(kb_ + r32 * KP + (16 * ks + 8 * h) * 2); kf[2 * k2 + 1] = *(const LAS bf16x8*)(kb_ + (32 + r32) * KP + (16 * ks + 8 * h) * 2); }
                __builtin_amdgcn_sched_barrier(0);
#pragma unroll
                for (int k2 = 0; k2 < 2; ++k2) { const int ks = 2 * kh + k2; sB0 = ATT_MFMA(kf[2 * k2], qfB[ks], sB0); sB1 = ATT_MFMA(kf[2 * k2 + 1], qfB[ks], sB1); }
                if (doA) {
#pragma unroll
                    for (int k2 = 0; k2 < 2; ++k2) { const int ks = 2 * kh + k2; sA0 = ATT_MFMA(kf[2 * k2], qfA[ks], sA0); sA1 = ATT_MFMA(kf[2 * k2 + 1], qfA[ks], sA1); }
                }
            }
            if (tix == tB) mask_blk(sB0, sB1, wqB + r32 - tk0 - 4 * h, 4096);
            u32x4 pA[4], pB[4];
            if (doA) {
                if (tix == tA) mask_blk(sA0, sA1, wqA + r32 - tk0 - 4 * h, 4096);
                softmax_blk(sA0, sA1, mA, lA, oA0, oA1, pA);
            }
            softmax_blk(sB0, sB1, mB, lB, oB0, oB1, pB);
#pragma unroll
            for (int idx = 0; idx < 4; ++idx) {
                const LAS unsigned char* vp_ = vb_ + (16 * idx) * KP + voff;
                const s16x4 a0 = vtr(vp_), a1 = vtr(vp_ + 8 * KP), b0 = vtr(vp_ + 64), b1 = vtr(vp_ + 8 * KP + 64);
                const bf16x8 vf0 = __builtin_shufflevector(a0, a1, 0, 1, 2, 3, 4, 5, 6, 7), vf1 = __builtin_shufflevector(b0, b1, 0, 1, 2, 3, 4, 5, 6, 7);
                const bf16x8 pfB = __builtin_bit_cast(bf16x8, pB[idx]);
                oB0 = ATT_MFMA(vf0, pfB, oB0); oB1 = ATT_MFMA(vf1, pfB, oB1);
                if (doA) { const bf16x8 pfA = __builtin_bit_cast(bf16x8, pA[idx]); oA0 = ATT_MFMA(vf0, pfA, oA0); oA1 = ATT_MFMA(vf1, pfA, oA1); }
            }
        }
        }
        if (more) { const int nb = (cur ^ 1) * 2 * BUF_B; *(LAS u32x4*)(lds + nb + soff) = kreg0; *(LAS u32x4*)(lds + nb + TILE_B + soff) = vreg0; *(LAS u32x4*)(lds + nb + BUF_B + soff) = kreg1; *(LAS u32x4*)(lds + nb + BUF_B + TILE_B + soff) = vreg1;
                    if (tid < 128) *(LAS float*)(lds + nb + coff) = creg; }
        __syncthreads();
    }
    store_blk(oA0, oA1, mA, lA, Oout + ((size_t)b * SEQ + wqA + r32) * 512 + hh * 64, nullptr, h);
    store_blk(oB0, oB1, mB, lB, Oout + ((size_t)b * SEQ + wqB + r32) * 512 + hh * 64, nullptr, h);
}
struct DilDesc { int bh, br, dd, p0, klo, nkt, rr0; };
__device__ __forceinline__ DilDesc dil_desc(int k, int vcu, int G) {
    DilDesc d; int i;
    if (G == 256) { const int xcd = vcu >> 5, c = vcu & 31, g = k / 3, sub = k - 3 * g; d.bh = 32 * xcd + 4 * g + (c >> 3); i = (c & 7) + 8 * sub; }
    else { const int u = vcu + k * G; d.bh = u & 255; i = u >> 8; }
    if (i < 8) { d.br = 0; d.dd = 1; d.p0 = 256 * i; d.rr0 = 0; }
    else if (i < 16) { d.br = 1; d.dd = 4; d.p0 = 256 * ((i - 8) & 1); d.rr0 = (i - 8) >> 1; }
    else { d.br = 2; d.dd = 16; d.p0 = 0; d.rr0 = 2 * (i - 16); }
    d.klo = d.p0 >= 128 ? d.p0 - 128 : 0; d.nkt = d.br == 2 ? 4 : (d.p0 + 256 - d.klo) >> 6;
    return d;
}
__device__ __forceinline__ void dil_compute(const LAS unsigned char* lds, const DilDesc& c, const bf16x8 (&qf)[4], int wave, int r32, int h, int voff, f32x16& o0, f32x16& o1, float& m, float& l, size_t& qrow) {
    const int seg = c.br == 2 ? (wave >> 2) : 0, wq0 = c.br == 2 ? 32 * (wave & 3) : c.p0 + 32 * wave, rr = c.rr0 + seg, klo = c.br == 2 ? 0 : c.klo;
    const LAS unsigned char* segb = lds + seg * 2 * TILE_B;
    m = 0.f; l = 0.f;
#pragma unroll
    for (int i = 0; i < 16; ++i) { o0[i] = 0.f; o1[i] = 0.f; }
    const int t_lo = (wq0 >= 128 ? wq0 - 128 : 0) >> 6, t_hi = wq0 >> 6;
    for (int t = t_lo; t <= t_hi; ++t) {
        const int tk0 = t * 64;
        const LAS unsigned char* kb_ = segb + (tk0 - klo) * KP; const LAS unsigned char* vb_ = kb_ + DIL_V;
        f32x16 s0, s1;
#pragma unroll
        for (int i = 0; i < 16; ++i) { s0[i] = -m; s1[i] = -m; }
#pragma unroll
        for (int kh = 0; kh < 2; ++kh) { bf16x8 kf[4];
#pragma unroll
            for (int k2 = 0; k2 < 2; ++k2) { const int ks = 2 * kh + k2; kf[2 * k2] = *(const LAS bf16x8*)(kb_ + r32 * KP + (16 * ks + 8 * h) * 2); kf[2 * k2 + 1] = *(const LAS bf16x8*)(kb_ + (32 + r32) * KP + (16 * ks + 8 * h) * 2); }
            __builtin_amdgcn_sched_barrier(0);
#pragma unroll
            for (int k2 = 0; k2 < 2; ++k2) { const int ks = 2 * kh + k2; s0 = ATT_MFMA(kf[2 * k2], qf[ks], s0); s1 = ATT_MFMA(kf[2 * k2 + 1], qf[ks], s1); }
        }
        if (tk0 + 63 > wq0 || wq0 + 31 - tk0 > 128) mask_blk(s0, s1, wq0 + r32 - tk0 - 4 * h, 128);
        u32x4 pw[4];
        softmax_blk(s0, s1, m, l, o0, o1, pw);
#pragma unroll
        for (int idx = 0; idx < 4; ++idx) {
            const LAS unsigned char* vp_ = vb_ + (16 * idx) * KP + voff;
            const s16x4 a0 = vtr(vp_), a1 = vtr(vp_ + 8 * KP), b0 = vtr(vp_ + 64), b1 = vtr(vp_ + 8 * KP + 64);
            const bf16x8 vf0 = __builtin_shufflevector(a0, a1, 0, 1, 2, 3, 4, 5, 6, 7), vf1 = __builtin_shufflevector(b0, b1, 0, 1, 2, 3, 4, 5, 6, 7);
            const bf16x8 pf = __builtin_bit_cast(bf16x8, pw[idx]);
            o0 = ATT_MFMA(vf0, pf, o0); o1 = ATT_MFMA(vf1, pf, o1);
        }
    }
    qrow = (size_t)(c.bh >> 3) * SEQ + (size_t)(wq0 + r32) * c.dd + rr;
}
__device__ __forceinline__ void dil_phase(LAS unsigned char* lds, const bf16_t* __restrict__ QKV, bf16_t* __restrict__ OD, float* __restrict__ LSE, int vcu, int G, int tid, int lane, int wave) {
    const int r32 = lane & 31, h = lane >> 5, skey = tid >> 3, sch = tid & 7, soff = skey * KP + sch * 16;
    const int i16 = lane & 15, vq = i16 >> 2, vp = i16 & 3, vblk = (lane >> 4) & 1;
    const int voff = (4 * h + vq) * KP + (16 * vblk + 4 * vp) * 2;
    const int nsteps = (G == 256) ? 24 : (24 * 256 - vcu + G - 1) / G;
    if (nsteps <= 0) return;
    u32x4 krA[6], vrA[6], krB[6], vrB[6]; bf16x8 qnA[4], qnB[4];
    DilDesc dA = dil_desc(0, vcu, G), dB = dA;
#define DIL_ISSUE(D, KR, VR, QN) do { \
        const bf16_t* base_ = QKV + (size_t)(3 * 256 + (D).bh) * HSTRIDE; \
        _Pragma("unroll") for (int j = 0; j < 6; ++j) if (j < (D).nkt) { \
            const int kpos_ = (D).br == 2 ? 64 * (j & 1) : (D).klo + 64 * j, rr_ = (D).br == 2 ? (D).rr0 + (j >> 1) : (D).rr0; \
            const bf16_t* g_ = base_ + SECS + (size_t)((kpos_ + skey) * (D).dd + rr_) * 64 + sch * 8; \
            KR[j] = *(const u32x4*)g_; VR[j] = *(const u32x4*)(g_ + SECS); } \
        { const int seg_ = (D).br == 2 ? (wave >> 2) : 0, wq_ = (D).br == 2 ? 32 * (wave & 3) : (D).p0 + 32 * wave; \
          const bf16_t* q_ = base_ + (size_t)((wq_ + r32) * (D).dd + (D).rr0 + seg_) * 64 + 8 * h; \
          _Pragma("unroll") for (int ks = 0; ks < 4; ++ks) QN[ks] = *(const bf16x8*)(q_ + 16 * ks); } } while (0)
    DIL_ISSUE(dA, krA, vrA, qnA);
    if (nsteps > 1) { dB = dil_desc(1, vcu, G); DIL_ISSUE(dB, krB, vrB, qnB); }
    bool pend = false; f32x16 po0, po1; float pm = 0.f, pl = 1.f; bf16_t* pop = OD; float* plp = LSE;
#pragma unroll
    for (int i = 0; i < 16; ++i) { po0[i] = 0.f; po1[i] = 0.f; }
#define DIL_STEP(D, KR, VR, QN, KIDX) do { \
        _Pragma("unroll") for (int j = 0; j < 6; ++j) if (j < (D).nkt) { *(LAS u32x4*)(lds + j * TILE_B + soff) = KR[j]; *(LAS u32x4*)(lds + DIL_V + j * TILE_B + soff) = VR[j]; } \
        bf16x8 qf[4]; \
        _Pragma("unroll") for (int ks = 0; ks < 4; ++ks) qf[ks] = QN[ks]; \
        asm volatile("s_waitcnt lgkmcnt(0)\n\ts_barrier" ::: "memory"); \
        const DilDesc c = (D); \
        if ((KIDX) + 2 < nsteps) { (D) = dil_desc((KIDX) + 2, vcu, G); DIL_ISSUE((D), KR, VR, QN); } \
        if (pend) store_blk(po0, po1, pm, pl, pop, plp, h); \
        size_t qrow; \
        dil_compute(lds, c, qf, wave, r32, h, voff, po0, po1, pm, pl, qrow); pend = true; \
        pop = OD + (size_t)c.br * OD_STRIDE + qrow * 512 + (c.bh & 7) * 64; plp = LSE + (size_t)c.br * MTOK * 8 + qrow * 8 + (c.bh & 7); \
        asm volatile("s_waitcnt lgkmcnt(0)\n\ts_barrier" ::: "memory"); } while (0)
    for (int k = 0; k < nsteps; k += 2) {
        DIL_STEP(dA, krA, vrA, qnA, k);
        if (k + 1 >= nsteps) break;
        DIL_STEP(dB, krB, vrB, qnB, k + 1);
    }
    if (pend) store_blk(po0, po1, pm, pl, pop, plp, h);
#undef DIL_STEP
#undef DIL_ISSUE
}
__device__ __forceinline__ void attn_phase(LAS unsigned char* lds, unsigned char* ws, int vcu, int G, int tid, int lane, int wave) {
    const bf16_t* QKV = (const bf16_t*)(ws + WS_QKV); const float* c2 = (const float*)(ws + WS_C2);
    bf16_t* OF = (bf16_t*)(ws + WS_OF); bf16_t* OD = (bf16_t*)(ws + WS_OD); float* LSE = (float*)(ws + WS_LSE);
    for (int u = vcu; u < 4 * 256; u += G) fox_unit(lds, QKV, c2, OF, u & 255, (3 - (u >> 8)) * 512, tid, lane, wave);
    dil_phase(lds, QKV, OD, LSE, vcu, G, tid, lane, wave);
}
}

#define RLX_AGENT __ATOMIC_RELAXED, __HIP_MEMORY_SCOPE_AGENT
#define XB_TMO      128
#define XB_XCNT(j)  (256  + 64 * (j))
#define XB_XSUB(j)  (1280 + 64 * (j))
#define XB_XGEN(j)  (2304 + 64 * (j))
#define XB_TOP      3328
#define XB_TOPGEN   3392
#define XCD_BAR_WORDS 3456
#define XB_SPIN_CAP (1u << 18)

__device__ __forceinline__ unsigned xb_ld(unsigned* p)              { return __hip_atomic_load(p, __ATOMIC_RELAXED, __HIP_MEMORY_SCOPE_AGENT); }
__device__ __forceinline__ unsigned xb_add(unsigned* p, unsigned v) { return __hip_atomic_fetch_add(p, v, __ATOMIC_RELAXED, __HIP_MEMORY_SCOPE_AGENT); }
__device__ __forceinline__ unsigned xb_xcc_id() { return (unsigned)__builtin_amdgcn_s_getreg((3 << 11) | 20) & 0xFu; }
#define XB_SPIN(cond, bar) do { unsigned _sp = 0; while (cond) { __builtin_amdgcn_s_sleep(1); \
    if ((++_sp & 255u) == 0u) { if (xb_ld(&(bar)[XB_TMO])) break; if (_sp > XB_SPIN_CAP) { atomicAdd(&(bar)[XB_TMO], 1u); break; } } } } while (0)

struct XcdBarrier {
    unsigned* bar; unsigned x;
    volatile LAS unsigned* st;
};

__device__ __forceinline__ XcdBarrier xcd_barrier_post(unsigned* bar, volatile LAS unsigned* st) {
    XcdBarrier b; b.bar = bar; b.x = xb_xcc_id(); b.st = st;
    if (threadIdx.x == 0) (void)xb_add(&bar[XB_XCNT(b.x)], 1u);
    return b;
}
__device__ __forceinline__ void xcd_barrier_complete(unsigned* bar, unsigned x, unsigned& nloc, unsigned& nx) {
    const unsigned G = gridDim.x * gridDim.y * gridDim.z;
    unsigned sum, cnt, mine, sp = 0u;
    for (;;) {
        sum = 0u; cnt = 0u; mine = 0u;
#pragma unroll
        for (unsigned j = 0; j < 16; ++j) { const unsigned c = xb_ld(&bar[XB_XCNT(j)]); sum += c; cnt += (c > 0u) ? 1u : 0u; mine = (j == x) ? c : mine; }
        if (sum == G) break;
        __builtin_amdgcn_s_sleep(1);
        if ((++sp & 255u) == 0u) { if (xb_ld(&bar[XB_TMO])) break; if (sp > XB_SPIN_CAP) { atomicAdd(&bar[XB_TMO], 1u); break; } }
    }
    nloc = mine > 0u ? mine : 1u; nx = cnt > 0u ? cnt : 1u;
}

__device__ __forceinline__ void xcd_barrier(const XcdBarrier& b) {
    asm volatile("s_waitcnt vmcnt(0)" ::: "memory");
    __syncthreads();
    if (threadIdx.x == 0) {
        unsigned* bar = b.bar;
        __builtin_amdgcn_s_waitcnt(0);
        unsigned nloc = b.st[0], nx = b.st[1];
        if (nloc == 0u) { xcd_barrier_complete(bar, b.x, nloc, nx); b.st[0] = nloc; b.st[1] = nx; }
        const unsigned old = xb_add(&bar[XB_XSUB(b.x)], 1u);
        const unsigned gen = old / nloc;
        if (old + 1u == (gen + 1u) * nloc) {
            __builtin_amdgcn_fence(__ATOMIC_RELEASE, "agent");
            asm volatile("s_waitcnt vmcnt(0)" ::: "memory");
            const unsigned og = xb_add(&bar[XB_TOP], 1u);
            const unsigned tg = og / nx;
            if (og + 1u == (tg + 1u) * nx) xb_add(&bar[XB_TOPGEN], 1u);
            else XB_SPIN(xb_ld(&bar[XB_TOPGEN]) == tg, bar);
            __builtin_amdgcn_fence(__ATOMIC_ACQUIRE, "agent");
            xb_add(&bar[XB_XGEN(b.x)], 1u);
            asm volatile("s_waitcnt vmcnt(0)" ::: "memory");
        } else {
            XB_SPIN(xb_ld(&bar[XB_XGEN(b.x)]) == gen, bar);
            __builtin_amdgcn_fence(__ATOMIC_ACQUIRE, "agent");
            asm volatile("s_waitcnt vmcnt(0)" ::: "memory");
        }
    }
    __syncthreads();
}

__global__ void __launch_bounds__(NTHREADS, 2) fwd_kernel(Args A) {
    extern __shared__ __attribute__((aligned(16))) unsigned char lds_raw[];
    LAS unsigned char* lds = (LAS unsigned char*)lds_raw;
    const int tid = threadIdx.x, lane = tid & 63, wave = __builtin_amdgcn_readfirstlane(tid >> 6);
    const int G = gridDim.x, bx = blockIdx.x, vcu = (G % 8 == 0) ? (bx % 8) * (G / 8) + bx / 8 : bx;
    unsigned char* ws = A.ws;
    const int lo = A.ph_lo, hi = A.ph_hi;
    volatile LAS unsigned* bst = (volatile LAS unsigned*)(lds + 131072);
    if (tid < 2) bst[tid] = 0u;
    __syncthreads();
    XcdBarrier bar = xcd_barrier_post((unsigned*)(ws + WS_CTL), bst);
#define IN(k) (lo <= (k) && (k) < hi)
#define SEAM(k) do { if (IN(k) && IN((k) + 1)) { xcd_barrier(bar); } } while (0)
    if (lo > 90) cg::this_grid().sync();
    if (IN(0)) { p0_prologue(A, lds, vcu, G, wave, lane); } SEAM(0);
    if (IN(1)) {
        cumsum_phase(A, vcu, G, wave, lane);
        pg8::Gemm g{(const bf16_t*)(ws + WS_XN), (const bf16_t*)(ws + WS_WQKV), MTOK, NQKV, DM}; pg8::StaticOrder S; S.init(MTOK, NQKV, G, bx);
        EpiQKV E{(bf16_t*)(ws + WS_QKV), (const float*)(ws + WS_GTAB), (const float*)(ws + WS_ROPE)};
        pg8::gemm_phase<EpiQKV, pg8::StaticOrder, true, true>(lds, g, S, E);
    } SEAM(1);
    if (IN(2)) {
        att::attn_phase(lds, ws, vcu, G, tid, lane, wave);
    } SEAM(2);
    if (IN(3)) { merge_phase(A, vcu, G, wave, lane); } SEAM(3);
    if (IN(4)) {
        pg8::Gemm g{(const bf16_t*)(ws + WS_ON), (const bf16_t*)(ws + WS_WO), MTOK, DM, DM}; pg8::StaticOrder S; S.init(MTOK, DM, G, bx);
        EpiOut E{A.x, (bf16_t*)(ws + WS_X1B), (float*)(ws + WS_SSQ)};
        pg8::gemm_phase<EpiOut, pg8::StaticOrder, true, true>(lds, g, S, E);
    } SEAM(4);
    if (IN(5)) {
        pg8::Gemm g{(const bf16_t*)(ws + WS_X1B), (const bf16_t*)(ws + WS_WGU), MTOK, NGU, DM}; pg8::StaticOrder S; S.init(MTOK, NGU, G, bx);
        EpiGU E{(bf16_t*)(ws + WS_H), (const float*)(ws + WS_SSQ), (LAS float*)(lds + 131072 + 256), -1};
        pg8::gemm_phase<EpiGU, pg8::StaticOrder, true, true>(lds, g, S, E);
    } SEAM(5);
    if (IN(6)) {
        pg8::Gemm g{(const bf16_t*)(ws + WS_H), (const bf16_t*)(ws + WS_WD), MTOK, DM, FF}; pg8::StaticOrder S; S.init(MTOK, DM, G, bx);
        EpiDown E{A.out, (const bf16_t*)(ws + WS_X1B)};
        pg8::gemm_phase<EpiDown, pg8::StaticOrder, true, true>(lds, g, S, E);
    }
#undef IN
#undef SEAM
}

extern "C" void kernel_launch(void* const* d_in, const int* in_sizes, int n_in, void* d_out, int out_size, void* d_ws, size_t ws_size, hipStream_t stream) {
    static int grid = 0;
    if (grid == 0) {
        if (n_in != 15 || out_size != MTOK * DM || ws_size < WS_END) { fprintf(stderr, "kernel_launch: unexpected shapes (n_in %d out %d ws %zu)\n", n_in, out_size, ws_size); grid = -1; return; }
        if (hipFuncSetAttribute((const void*)fwd_kernel, hipFuncAttributeMaxDynamicSharedMemorySize, LDS_BYTES) != hipSuccess) { fprintf(stderr, "kernel_launch: hipFuncSetAttribute failed\n"); grid = -1; return; }
        int dev = 0, cus = 0, per_cu = 0;
        hipGetDevice(&dev); hipDeviceGetAttribute(&cus, hipDeviceAttributeMultiprocessorCount, dev);
        hipOccupancyMaxActiveBlocksPerMultiprocessor(&per_cu, (const void*)fwd_kernel, NTHREADS, LDS_BYTES);
        (void)hipGetLastError();
        grid = (cus > 0 ? cus : 256) * (per_cu > 0 ? per_cu : 1);
        fprintf(stderr, "kernel_launch: cus %d per_cu %d grid %d\n", cus, per_cu, grid);
    }
    if (grid < 0) return;
    Args a{};
    a.x = (const float*)d_in[0]; a.g_mix = (const float*)d_in[1]; a.w_in = (const float*)d_in[2]; a.b_forget = (const float*)d_in[3]; a.g_q_fox = (const float*)d_in[4]; a.g_k_fox = (const float*)d_in[5];
    a.g_q_dil = (const float*)d_in[6]; a.g_k_dil = (const float*)d_in[7]; a.g_out_fox = (const float*)d_in[8]; a.g_out_dil = (const float*)d_in[9]; a.w_out = (const float*)d_in[10]; a.g_ffn = (const float*)d_in[11];
    a.w_gate = (const float*)d_in[12]; a.w_up = (const float*)d_in[13]; a.w_down = (const float*)d_in[14];
    a.out = (float*)d_out; a.ws = (unsigned char*)d_ws;
    a.ph_lo = 0; a.ph_hi = 7;
    if (hipMemsetAsync((unsigned char*)d_ws + WS_CTL, 0, CTL_BYTES, stream) != hipSuccess) { fprintf(stderr, "kernel_launch: memset failed\n"); return; }
    void* kargs[] = {&a};
    hipError_t e = hipLaunchCooperativeKernel((const void*)fwd_kernel, dim3(grid), dim3(NTHREADS), kargs, LDS_BYTES, stream);
    if (e != hipSuccess) fprintf(stderr, "kernel_launch: cooperative launch failed: %s (grid %d)\n", hipGetErrorString(e), grid);
}
```

```cpp
#include <hip/hip_runtime.h>
#include <hip/hip_cooperative_groups.h>
#include <cstdio>
#include <cstdint>
namespace cg = cooperative_groups;
namespace pg8 {
#define PG8_LAS __attribute__((address_space(3)))
typedef unsigned short bf16_t;
typedef short bf16x8 __attribute__((ext_vector_type(8)));
typedef float f32x4 __attribute__((ext_vector_type(4)));
typedef unsigned u32x4 __attribute__((ext_vector_type(4)));
constexpr int BM = 256, BK = 64, HALF = 128, HTB = HALF * BK * 2  , STAGE_BYTES = 8 * HTB, NXCD = 8, WGM = 8;

__host__ __device__ __forceinline__ int lds_byte(int r, int c) { const int st = (r >> 4) * 2 + (c >> 5), rr = r & 15, cc = c & 31, ob = rr * 64 + cc * 2; return st * 1024 + (ob ^ (((ob >> 9) & 1) << 5)); }
__host__ __device__ __forceinline__ void stage_rc(int b, int& R, int& C) { const int st = b / 1024, sb = b % 1024, swz = sb ^ (((sb >> 9) & 1) << 5); R = (st >> 1) * 16 + swz / 64; C = (st & 1) * 32 + (swz % 64) / 2; }
__host__ __device__ __forceinline__ int perm32(int rho) { const int n = rho >> 4, i = rho & 15; return 8 * (i >> 2) + 4 * n + (i & 3); }

struct Unit { int pm, pn; };
struct Gemm { const bf16_t* A; const bf16_t* Bt; int M, N, K; };

struct StaticOrder {
    int nM, nN, nwg, G, c;
    __host__ __device__ void init(int M, int N, int G_, int c_) { nM = M / BM; nN = N / BM; nwg = nM * nN; G = G_; c = c_; }
    __host__ __device__ bool next(int i, Unit& u) const {
        const long L = (long)i * G + c; if (L >= nwg) return false;
        int wgid = (int)L; { const int q = nwg / NXCD, r = nwg % NXCD, xcd = wgid % NXCD, off = wgid / NXCD; wgid = (xcd < r ? xcd * (q + 1) : r * (q + 1) + (xcd - r) * q) + off; }
        const int nig = WGM * nN, gid = wgid / nig, fm = gid * WGM, gsz = (nM - fm) < WGM ? (nM - fm) : WGM;
        u.pm = fm + ((wgid % nig) % gsz); u.pn = (wgid % nig) / gsz; return true;
    }
    __device__ __forceinline__ void a_ready(const Unit&) const {}
    __device__ __forceinline__ void done(const Unit&) const {}
};

__device__ __forceinline__ unsigned cvt_pk_bf16(float lo, float hi) { unsigned r; asm volatile("v_cvt_pk_bf16_f32 %0, %1, %2" : "=v"(r) : "v"(lo), "v"(hi)); return r; }
template <class Epi, class Sched, bool ALIGN_EPI = false, bool SP2 = false>
__device__ __forceinline__ void gemm_phase(PG8_LAS unsigned char* lds, const Gemm g, const Sched& S, const Epi& E) {
    const int tid = threadIdx.x, wid = __builtin_amdgcn_readfirstlane(tid >> 6), lane = tid & 63, wr = wid >> 2, wc = wid & 3, fr = lane & 15, fq = lane >> 4;
    const int K = g.K, nt = K / BK;
    unsigned voffA[2], voffB[2];
#pragma unroll
    for (int i = 0; i < 2; ++i) { int R, C; stage_rc(tid * 16 + i * 8192, R, C); const int Rb = Epi::PERM ? ((R & ~31) + perm32(R & 31)) : R;
        voffA[i] = (unsigned)(R * K + C) * 2u; voffB[i] = (unsigned)(Rb * K + C) * 2u; }
    const size_t kstep = (size_t)(BK * 2);
    const size_t hstep = (size_t)HALF * K * 2;
    const size_t tstep = 2 * hstep;
    const unsigned ldsw = (unsigned)wid * 1024u;
    const int aoff = lds_byte(wr * 64 + fr, fq * 8), boff = lds_byte(wc * 32 + fr, fq * 8);
#define PG8_SA(b, h) (((b) * 2 + (h)) * HTB)
#define PG8_SB(b, h) ((4 + (b) * 2 + (h)) * HTB)
#define PG8_STAGE(bufoff, gbase, voff) do { _Pragma("unroll") for (int _i = 0; _i < 2; ++_i) \
        __builtin_amdgcn_global_load_lds((const unsigned*)((const char*)(gbase) + (voff)[_i]), (PG8_LAS unsigned*)(lds + (bufoff) + ldsw + _i * 8192), 16, 0, 0); } while (0)
#define PG8_LDA(dst, b, h) do { _Pragma("unroll") for (int m = 0; m < 4; ++m) _Pragma("unroll") for (int k = 0; k < 2; ++k) dst[m][k] = *(const PG8_LAS bf16x8*)(lds + PG8_SA(b, h) + aoff + m * 2048 + k * 1024); } while (0)
#define PG8_LDB(dst, b, h) do { _Pragma("unroll") for (int n = 0; n < 2; ++n) _Pragma("unroll") for (int k = 0; k < 2; ++k) dst[n][k] = *(const PG8_LAS bf16x8*)(lds + PG8_SB(b, h) + boff + n * 2048 + k * 1024); } while (0)
#define PG8_MMA(ai, bj, At, Bt) do { __builtin_amdgcn_s_setprio(1); _Pragma("unroll") for (int m = 0; m < 4; ++m) _Pragma("unroll") for (int n = 0; n < 2; ++n) _Pragma("unroll") for (int k = 0; k < 2; ++k) \
        acc[ai][bj][m][n] = __builtin_amdgcn_mfma_f32_16x16x32_bf16(Bt[n][k], At[m][k], acc[ai][bj][m][n], 0, 0, 0); __builtin_amdgcn_s_setprio(0); } while (0)
#define PG8_WAIT_V(n) asm volatile("s_waitcnt vmcnt(" #n ")" ::: "memory")
#define PG8_WAIT_L(n) asm volatile("s_waitcnt lgkmcnt(" #n ")" ::: "memory")
#define PG8_BAR __builtin_amdgcn_s_barrier()
#define PG8_SCHED __builtin_amdgcn_sched_barrier(0)
    Unit cur, nxt; int ui = 0;
    if (!S.next(0, cur)) return;
    f32x4 acc[2][2][4][2];
#pragma unroll
    for (int a = 0; a < 2; ++a)
#pragma unroll
        for (int b = 0; b < 2; ++b)
#pragma unroll
            for (int m = 0; m < 4; ++m)
#pragma unroll
                for (int n = 0; n < 2; ++n) acc[a][b][m][n] = (f32x4){0.f, 0.f, 0.f, 0.f};
    bf16x8 At[4][2], B0[2][2], B1[2][2];
    const char* cA = (const char*)g.A + (size_t)cur.pm * tstep; const char* cB = (const char*)g.Bt + (size_t)cur.pn * tstep;
    S.a_ready(cur);
    if constexpr (SP2) {
        PG8_STAGE(PG8_SB(0, 0), cB, voffB); PG8_STAGE(PG8_SB(0, 1), cB + hstep, voffB); PG8_STAGE(PG8_SA(0, 0), cA, voffA); PG8_STAGE(PG8_SA(0, 1), cA + hstep, voffA);
        if (wr == 1) PG8_BAR;
        PG8_WAIT_V(2); PG8_BAR;
        PG8_STAGE(PG8_SB(1, 0), cB + kstep, voffB); PG8_STAGE(PG8_SA(1, 0), cA + kstep, voffA); PG8_STAGE(PG8_SB(1, 1), cB + hstep + kstep, voffB);
        PG8_WAIT_V(6); PG8_BAR;
    } else {
        PG8_STAGE(PG8_SB(0, 0), cB, voffB); PG8_STAGE(PG8_SA(0, 0), cA, voffA); PG8_STAGE(PG8_SB(0, 1), cB + hstep, voffB); PG8_STAGE(PG8_SA(0, 1), cA + hstep, voffA);
        if (wr == 1) PG8_BAR;
        PG8_WAIT_V(4); PG8_BAR;
        PG8_STAGE(PG8_SB(1, 0), cB + kstep, voffB); PG8_STAGE(PG8_SA(1, 0), cA + kstep, voffA); PG8_STAGE(PG8_SB(1, 1), cB + hstep + kstep, voffB);
        PG8_WAIT_V(6); PG8_BAR;
    }
    for (;;) {
        const bool has_next = S.next(ui + 1, nxt);
        const char* nA = has_next ? (const char*)g.A + (size_t)nxt.pm * tstep : cA; const char* nB = has_next ? (const char*)g.Bt + (size_t)nxt.pn * tstep : cB;
        for (int t = 0; t < nt; t += 2) {
            const bool last = (t == nt - 2);
            const char* a1 = cA + (size_t)(t + 1) * kstep;
            const char* a2 = last ? nA : cA + (size_t)(t + 2) * kstep; const char* b2 = last ? nB : cB + (size_t)(t + 2) * kstep;
            const char* a3 = a2 + kstep; const char* b3 = b2 + kstep;
            if (last && has_next) S.a_ready(nxt);
            if constexpr (SP2) {
            PG8_LDB(B0, 0, 0); PG8_LDB(B1, 0, 1); PG8_SCHED; PG8_LDA(At, 0, 0); PG8_STAGE(PG8_SA(1, 1), a1 + hstep, voffA);
            PG8_WAIT_V(8); PG8_WAIT_L(0); PG8_BAR; PG8_MMA(0, 0, At, B0); PG8_MMA(0, 1, At, B1); PG8_BAR; PG8_SCHED;
            PG8_LDA(At, 0, 1); PG8_STAGE(PG8_SB(0, 0), b2, voffB); PG8_STAGE(PG8_SB(0, 1), b2 + hstep, voffB); PG8_STAGE(PG8_SA(0, 0), a2, voffA);
            PG8_WAIT_V(8); PG8_WAIT_L(0); PG8_BAR; PG8_MMA(1, 0, At, B0); PG8_MMA(1, 1, At, B1); PG8_BAR; PG8_SCHED;
            PG8_LDB(B0, 1, 0); PG8_LDB(B1, 1, 1); PG8_SCHED; PG8_LDA(At, 1, 0); PG8_STAGE(PG8_SA(0, 1), a2 + hstep, voffA);
            PG8_WAIT_V(8); PG8_WAIT_L(0); PG8_BAR; PG8_MMA(0, 0, At, B0); PG8_MMA(0, 1, At, B1); PG8_BAR; PG8_SCHED;
            PG8_LDA(At, 1, 1); PG8_STAGE(PG8_SB(1, 0), b3, voffB); PG8_STAGE(PG8_SB(1, 1), b3 + hstep, voffB); PG8_STAGE(PG8_SA(1, 0), a3, voffA);
            PG8_WAIT_V(8); PG8_WAIT_L(0); PG8_BAR; PG8_MMA(1, 0, At, B0); PG8_MMA(1, 1, At, B1); PG8_BAR; PG8_SCHED;
            } else {
            PG8_LDB(B0, 0, 0); PG8_SCHED; PG8_LDA(At, 0, 0); PG8_STAGE(PG8_SA(1, 1), a1 + hstep, voffA);
            PG8_WAIT_L(8); PG8_BAR; PG8_WAIT_L(0); PG8_MMA(0, 0, At, B0); PG8_BAR; PG8_SCHED;
            PG8_LDB(B1, 0, 1); PG8_STAGE(PG8_SB(0, 0), b2, voffB);
            PG8_BAR; PG8_WAIT_L(0); PG8_MMA(0, 1, At, B1); PG8_BAR;
            PG8_LDA(At, 0, 1); PG8_STAGE(PG8_SA(0, 0), a2, voffA);
            PG8_BAR; PG8_WAIT_L(0); PG8_MMA(1, 0, At, B0); PG8_BAR; PG8_SCHED;
            PG8_STAGE(PG8_SB(0, 1), b2 + hstep, voffB);
            PG8_WAIT_V(6); PG8_BAR; PG8_MMA(1, 1, At, B1); PG8_BAR;
            PG8_LDB(B0, 1, 0); PG8_SCHED; PG8_LDA(At, 1, 0); PG8_STAGE(PG8_SA(0, 1), a2 + hstep, voffA);
            PG8_WAIT_L(8); PG8_BAR; PG8_WAIT_L(0); PG8_MMA(0, 0, At, B0); PG8_BAR; PG8_SCHED;
            PG8_LDB(B1, 1, 1); PG8_STAGE(PG8_SB(1, 0), b3, voffB);
            PG8_BAR; PG8_WAIT_L(0); PG8_MMA(0, 1, At, B1); PG8_BAR;
            PG8_LDA(At, 1, 1); PG8_STAGE(PG8_SA(1, 0), a3, voffA);
            PG8_BAR; PG8_WAIT_L(0); PG8_MMA(1, 0, At, B0); PG8_BAR; PG8_SCHED;
            PG8_STAGE(PG8_SB(1, 1), b3 + hstep, voffB);
            PG8_WAIT_V(6); PG8_BAR; PG8_MMA(1, 1, At, B1); PG8_BAR;
            }
        }
        if constexpr (ALIGN_EPI) { if (wr == 0) PG8_BAR; }
        if constexpr (!Epi::AFTER_DRAIN) { E(acc, cur, wr, wc, fr, fq); S.done(cur); }
        if (!has_next) break;
#pragma unroll
        for (int a = 0; a < 2; ++a)
#pragma unroll
            for (int b = 0; b < 2; ++b)
#pragma unroll
                for (int m = 0; m < 4; ++m)
#pragma unroll
                    for (int n = 0; n < 2; ++n) acc[a][b][m][n] = (f32x4){0.f, 0.f, 0.f, 0.f};
        cur = nxt; cA = nA; cB = nB; ++ui;
        if constexpr (ALIGN_EPI) { if (wr == 1) PG8_BAR; }
    }
    PG8_WAIT_V(0);
    if constexpr (!ALIGN_EPI) { if (wr == 0) PG8_BAR; }
    PG8_BAR;
    if constexpr (Epi::AFTER_DRAIN) { E.fused(acc, cur, wr, wc, fr, fq, lds, wid, lane); S.done(cur); }
#undef PG8_SA
#undef PG8_SB
#undef PG8_STAGE
#undef PG8_LDA
#undef PG8_LDB
#undef PG8_MMA
#undef PG8_WAIT_V
#undef PG8_WAIT_L
#undef PG8_BAR
#undef PG8_SCHED
}
}

constexpr int BATCH = 32, SEQ = 2048, DM = 1024, MTOK = BATCH * SEQ, NQKV = 3072, FF = 2816, NGU = 2 * FF, INC = 3080;
constexpr float EPS = 1e-6f, LOG2E = 1.4426950408889634f, QSCALE = 0.125f * LOG2E;
constexpr int NTHREADS = 512, NWAVES = 8;
constexpr int LDS_BYTES = 131072 + 256 + 4096 + 256 + 4 * 4352;
constexpr size_t MiB = 1u << 20;
constexpr size_t WS_GTAB = 25 * MiB + 512 * 1024, WS_CTL = 25 * MiB + 768 * 1024, CTL_BYTES = 16384;
constexpr size_t WS_WQKV = 0, WS_WO = 6 * MiB, WS_WGU = 8 * MiB, WS_WD = 19 * MiB, WS_ROPE = 25 * MiB, WS_LOGF = 26 * MiB, WS_C2 = 28 * MiB, WS_SSQ = 30 * MiB, WS_LSE = 34 * MiB;
constexpr size_t WS_QKV = 40 * MiB, WS_XN = 432 * MiB, WS_OF = 560 * MiB, WS_OD = 624 * MiB, WS_ON = WS_XN, WS_X1B = WS_QKV, WS_H = 168 * MiB, WS_END = 816 * MiB;
constexpr size_t OD_STRIDE = (size_t)MTOK * 512;
constexpr size_t HSTRIDE = (size_t)SEQ * 64 + 2048, SECS = (size_t)256 * HSTRIDE;

#define LAS __attribute__((address_space(3)))
typedef pg8::bf16_t bf16_t;
typedef pg8::f32x4 f32x4;
typedef pg8::u32x4 u32x4;
typedef unsigned u32x2 __attribute__((ext_vector_type(2)));
using pg8::cvt_pk_bf16;
__device__ __forceinline__ float bf2f(unsigned short v) { return __uint_as_float((unsigned)v << 16); }
__device__ __forceinline__ float wave_sum(float v) {
#pragma unroll
    for (int o = 1; o < 64; o <<= 1) v += __shfl_xor(v, o);
    return v;
}

__device__ __forceinline__ float xsum16(float x) { auto r = __builtin_amdgcn_permlane16_swap(__float_as_uint(x), __float_as_uint(x), false, false); return __uint_as_float(r[0]) + __uint_as_float(r[1]); }
__device__ __forceinline__ float xsum32(float x) { auto r = __builtin_amdgcn_permlane32_swap(__float_as_uint(x), __float_as_uint(x), false, false); return __uint_as_float(r[0]) + __uint_as_float(r[1]); }

struct Args {
    const float* x; const float* g_mix; const float* w_in; const float* b_forget; const float* g_q_fox; const float* g_k_fox; const float* g_q_dil; const float* g_k_dil;
    const float* g_out_fox; const float* g_out_dil; const float* w_out; const float* g_ffn; const float* w_gate; const float* w_up; const float* w_down;
    float* out; unsigned char* ws; int ph_lo, ph_hi;
};

struct EpiQKV {
    static constexpr bool PERM = true, AFTER_DRAIN = false;
    bf16_t* O; const float* gtab; const float* rope;
    __device__ __forceinline__ void operator()(const f32x4 (&acc)[2][2][4][2], const pg8::Unit& u, int wr, int wc, int fr, int fq) const {
        const int sec = u.pn >> 1;
        const bool isv = (sec == 2) || (sec == 5), isq = (sec == 0) || (sec == 3), dil = sec >= 3;
        const float* g = gtab + sec * 64;
        const size_t hbase = ((size_t)sec * 256 + (u.pn & 1) * 4 + wc) * HSTRIDE + fq * 8;
        const float qs = isq ? QSCALE : 1.f;
        f32x4 gv[2][2];
#pragma unroll
        for (int bj = 0; bj < 2; ++bj)
#pragma unroll
            for (int n = 0; n < 2; ++n) gv[bj][n] = *(const f32x4*)(g + bj * 32 + fq * 8 + n * 4) * qs;
        const bool rotu = dil && !isv;
        const bool rot = rotu && fq < 2;
        const float sgn = (fq == 0) ? -1.f : 1.f;
#pragma unroll
        for (int ai = 0; ai < 2; ++ai) {
            f32x4 cs[4][2][2];
            if (rot) {
#pragma unroll
                for (int m = 0; m < 4; ++m) { const float* rp = rope + (size_t)((u.pm * 256 + ai * 128 + wr * 64 + m * 16 + fr) & (SEQ - 1)) * 16;
#pragma unroll
                    for (int n = 0; n < 2; ++n) { cs[m][n][0] = *(const f32x4*)(rp + n * 8); cs[m][n][1] = *(const f32x4*)(rp + n * 8 + 4); } }
            }
#pragma unroll
            for (int m = 0; m < 4; ++m) {
                const int row = u.pm * 256 + ai * 128 + wr * 64 + m * 16 + fr;
                f32x4 v[2][2];
#pragma unroll
                for (int bj = 0; bj < 2; ++bj)
#pragma unroll
                    for (int n = 0; n < 2; ++n) v[bj][n] = acc[ai][bj][m][n];
                if (!isv) {
                    float ss = 0.f;
#pragma unroll
                    for (int bj = 0; bj < 2; ++bj)
#pragma unroll
                        for (int n = 0; n < 2; ++n) ss += (v[bj][n][0] * v[bj][n][0] + v[bj][n][1] * v[bj][n][1]) + (v[bj][n][2] * v[bj][n][2] + v[bj][n][3] * v[bj][n][3]);
                    ss = xsum32(xsum16(ss));
                    const float rs = __builtin_amdgcn_rsqf(ss * (1.f / 64.f) + EPS);
#pragma unroll
                    for (int bj = 0; bj < 2; ++bj)
#pragma unroll
                        for (int n = 0; n < 2; ++n) v[bj][n] = v[bj][n] * rs * gv[bj][n];
                    if (rotu) {
#pragma unroll
                        for (int n = 0; n < 2; ++n) {
                            f32x4 pr;
#pragma unroll
                            for (int e = 0; e < 4; ++e) { auto r = __builtin_amdgcn_permlane16_swap(__float_as_uint(v[0][n][e]), __float_as_uint(v[0][n][e]), false, false);
                                pr[e] = __uint_as_float((fq & 1) ? r[0] : r[1]); }
                            if (rot) {
                                const f32x4 cs0 = cs[m][n][0], cs1 = cs[m][n][1];
                                const f32x4 x = v[0][n];
                                v[0][n] = (f32x4){x[0] * cs0[0] + sgn * pr[0] * cs0[1], x[1] * cs0[2] + sgn * pr[1] * cs0[3], x[2] * cs1[0] + sgn * pr[2] * cs1[1], x[3] * cs1[2] + sgn * pr[3] * cs1[3]};
                            }
                        }
                    }
                }
                bf16_t* rowp = O + hbase + (size_t)(row >> 11) * 8 * HSTRIDE + (size_t)(row & (SEQ - 1)) * 64;
#pragma unroll
                for (int bj = 0; bj < 2; ++bj) {
                    u32x4 w; w.x = cvt_pk_bf16(v[bj][0][0], v[bj][0][1]); w.y = cvt_pk_bf16(v[bj][0][2], v[bj][0][3]); w.z = cvt_pk_bf16(v[bj][1][0], v[bj][1][1]); w.w = cvt_pk_bf16(v[bj][1][2], v[bj][1][3]);
                    *(u32x4*)(rowp + bj * 32) = w;
                }
            }
        }
    }
};
struct EpiOut {
    static constexpr bool PERM = false, AFTER_DRAIN = false;
    const float* x; bf16_t* x1b; float* ssq;
    __device__ __forceinline__ void operator()(const f32x4 (&acc)[2][2][4][2], const pg8::Unit& u, int wr, int wc, int fr, int fq) const {
        const int col0 = u.pn * 256 + wc * 32 + 4 * fq;
#pragma unroll
        for (int ai = 0; ai < 2; ++ai) {
            f32x4 xr[4][2][2];
#pragma unroll
            for (int m = 0; m < 4; ++m)
#pragma unroll
                for (int bj = 0; bj < 2; ++bj)
#pragma unroll
                    for (int n = 0; n < 2; ++n) xr[m][bj][n] = *(const f32x4*)(x + (size_t)(u.pm * 256 + ai * 128 + wr * 64 + m * 16 + fr) * DM + col0 + bj * 128 + n * 16);
            __builtin_amdgcn_sched_barrier(0);
#pragma unroll
            for (int m = 0; m < 4; ++m) {
                const int row = u.pm * 256 + ai * 128 + wr * 64 + m * 16 + fr;
                float ss = 0.f;
#pragma unroll
                for (int bj = 0; bj < 2; ++bj)
#pragma unroll
                    for (int n = 0; n < 2; ++n) {
                        const size_t off = (size_t)row * DM + col0 + bj * 128 + n * 16;
                        const f32x4 o = xr[m][bj][n] + acc[ai][bj][m][n];
                        ss += (o[0] * o[0] + o[1] * o[1]) + (o[2] * o[2] + o[3] * o[3]);
                        u32x2 w; w.x = cvt_pk_bf16(o[0], o[1]); w.y = cvt_pk_bf16(o[2], o[3]);
                        *(u32x2*)(x1b + off) = w;
                    }
                ss = xsum32(xsum16(ss));
                if (fq == 0) ssq[(size_t)(u.pn * 4 + wc) * MTOK + row] = ss;
            }
        }
    }
};
struct EpiGU {
    static constexpr bool PERM = true, AFTER_DRAIN = false;
    bf16_t* H; const float* ssq; LAS float* rtab; mutable int last_pm;
    __device__ __forceinline__ void operator()(const f32x4 (&acc)[2][2][4][2], const pg8::Unit& u, int wr, int wc, int fr, int fq) const {
        const int col0 = u.pn * 128 + wc * 32 + 8 * fq;
        LAS float* rt = rtab + wc * 256 + wr * 64 + fr;
        if (u.pm != last_pm) {
            last_pm = u.pm;
            float pp[2][4];
#pragma unroll
            for (int ai = 0; ai < 2; ++ai)
#pragma unroll
                for (int m = 0; m < 4; ++m) { const int row = u.pm * 256 + ai * 128 + wr * 64 + m * 16 + fr; float p = 0.f;
#pragma unroll
                    for (int j = 0; j < 4; ++j) p += ssq[(size_t)(fq * 4 + j) * MTOK + row];
                    pp[ai][m] = p; }
#pragma unroll
            for (int ai = 0; ai < 2; ++ai)
#pragma unroll
                for (int m = 0; m < 4; ++m) { const float p = xsum32(xsum16(pp[ai][m])); if (fq == 0) rt[ai * 128 + m * 16] = __builtin_amdgcn_rsqf(p * (1.f / DM) + EPS); }
        }
#pragma unroll
        for (int ai = 0; ai < 2; ++ai)
#pragma unroll
            for (int m = 0; m < 4; ++m) {
                const int row = u.pm * 256 + ai * 128 + wr * 64 + m * 16 + fr;
                const float rs = rt[ai * 128 + m * 16];
                typedef float f32x2 __attribute__((ext_vector_type(2)));
                const float kneg = -rs * LOG2E, rs2 = rs * rs;
                float hv[8];
#pragma unroll
                for (int n = 0; n < 2; ++n)
#pragma unroll
                    for (int e2 = 0; e2 < 2; ++e2) {
                        const f32x2 gg = {acc[ai][0][m][n][2 * e2], acc[ai][0][m][n][2 * e2 + 1]}, uu = {acc[ai][1][m][n][2 * e2], acc[ai][1][m][n][2 * e2 + 1]};
                        const f32x2 t = gg * kneg, pq = (gg * uu) * rs2;
                        f32x2 d; d.x = __builtin_amdgcn_exp2f(t.x); d.y = __builtin_amdgcn_exp2f(t.y);
                        d = d + 1.0f;
                        f32x2 r; r.x = __builtin_amdgcn_rcpf(d.x); r.y = __builtin_amdgcn_rcpf(d.y);
                        const f32x2 o = pq * r;
                        hv[n * 4 + 2 * e2] = o.x; hv[n * 4 + 2 * e2 + 1] = o.y;
                    }
                u32x4 w; w.x = cvt_pk_bf16(hv[0], hv[1]); w.y = cvt_pk_bf16(hv[2], hv[3]); w.z = cvt_pk_bf16(hv[4], hv[5]); w.w = cvt_pk_bf16(hv[6], hv[7]);
                *(u32x4*)(H + (size_t)row * FF + col0) = w;
            }
    }
};
struct EpiDown {
    static constexpr bool PERM = false, AFTER_DRAIN = false;
    float* out; const bf16_t* x1b;
    __device__ __forceinline__ void operator()(const f32x4 (&acc)[2][2][4][2], const pg8::Unit& u, int wr, int wc, int fr, int fq) const {
        const int col0 = u.pn * 256 + wc * 32 + 4 * fq;
        u32x2 xw[2][4][2][2];
#pragma unroll
        for (int ai = 0; ai < 2; ++ai)
#pragma unroll
            for (int m = 0; m < 4; ++m)
#pragma unroll
                for (int bj = 0; bj < 2; ++bj)
#pragma unroll
                    for (int n = 0; n < 2; ++n) xw[ai][m][bj][n] = *(const u32x2*)(x1b + (size_t)(u.pm * 256 + ai * 128 + wr * 64 + m * 16 + fr) * DM + col0 + bj * 128 + n * 16);
        __builtin_amdgcn_sched_barrier(0);
#pragma unroll
        for (int ai = 0; ai < 2; ++ai)
#pragma unroll
            for (int m = 0; m < 4; ++m) {
                const int row = u.pm * 256 + ai * 128 + wr * 64 + m * 16 + fr;
#pragma unroll
                for (int bj = 0; bj < 2; ++bj)
#pragma unroll
                    for (int n = 0; n < 2; ++n) {
                        const size_t off = (size_t)row * DM + col0 + bj * 128 + n * 16;
                        const u32x2 w = xw[ai][m][bj][n];
                        const f32x4 xr = {__uint_as_float(w.x << 16), __uint_as_float(w.x & 0xffff0000u), __uint_as_float(w.y << 16), __uint_as_float(w.y & 0xffff0000u)};
                        *(f32x4*)(out + off) = xr + acc[ai][bj][m][n];
                    }
            }
    }
};
template <int WHICH> __device__ __forceinline__ void tr_item(const float* W, const float* W2, const float* gk, bf16_t* WT, int K, int Nsrc, int Nd, LAS float* scr, int item, int lane) {
    const int nblk = Nd / 32, kb = item / nblk, nb = item % nblk, k0 = 64 * kb, c0 = 32 * nb;
    const int c = c0 + (lane & 31);
    int sc; const float* src = W;
    if (WHICH == 0) { const int pn = c >> 8, cp = c & 255; const int bc = pn * 256 + ((cp >> 5) & 3) * 64 + (cp >> 7) * 32 + ((cp >> 3) & 3) * 8 + (cp & 7); sc = bc < 1536 ? bc : bc + 8; }
    else if (WHICH == 2) { const int pn = c >> 8, cp = c & 255; sc = pn * 128 + (cp & 127); src = (cp >> 7) ? W2 : W; }
    else sc = c;
#pragma unroll 8
    for (int i = 0; i < 32; ++i) { const int kk = 2 * i + (lane >> 5); float v = __builtin_nontemporal_load(src + (size_t)(k0 + kk) * Nsrc + sc); if (gk) v *= gk[k0 + kk]; scr[kk * 33 + (lane & 31)] = v; }
    asm volatile("s_waitcnt lgkmcnt(0)" ::: "memory");
    const int c8 = lane & 7;
#pragma unroll
    for (int j = 0; j < 4; ++j) { const int n = (lane >> 3) + 8 * j; const LAS float* s = scr + (8 * c8) * 33 + n;
        u32x4 o; o.x = cvt_pk_bf16(s[0 * 33], s[1 * 33]); o.y = cvt_pk_bf16(s[2 * 33], s[3 * 33]); o.z = cvt_pk_bf16(s[4 * 33], s[5 * 33]); o.w = cvt_pk_bf16(s[6 * 33], s[7 * 33]);
        *(u32x4*)(WT + (size_t)(c0 + n) * K + k0 + 8 * c8) = o; }
    asm volatile("s_waitcnt lgkmcnt(0)" ::: "memory");
}
__device__ __forceinline__ void p0_prologue(const Args& A, LAS unsigned char* lds, int vcu, int G, int wave, int lane) {
    unsigned char* ws = A.ws;
    LAS float* scr = (LAS float*)(lds + wave * 16384);
    const int gw = vcu * NWAVES + wave, NGW = G * NWAVES;
    constexpr int I_QKV = (DM / 64) * (NQKV / 32), I_O = (DM / 64) * (DM / 32), I_GU = (DM / 64) * (NGU / 32), I_D = (FF / 64) * (DM / 32), NITEMS = I_QKV + I_O + I_GU + I_D;
    for (int it = gw; it < NITEMS; it += NGW) {
        int r = it;
        if (r < I_QKV) { tr_item<0>(A.w_in, nullptr, nullptr, (bf16_t*)(ws + WS_WQKV), DM, INC, NQKV, scr, r, lane); continue; } r -= I_QKV;
        if (r < I_O) { tr_item<1>(A.w_out, nullptr, nullptr, (bf16_t*)(ws + WS_WO), DM, DM, DM, scr, r, lane); continue; } r -= I_O;
        if (r < I_GU) { tr_item<2>(A.w_gate, A.w_up, A.g_ffn, (bf16_t*)(ws + WS_WGU), DM, FF, NGU, scr, r, lane); continue; } r -= I_GU;
        tr_item<1>(A.w_down, nullptr, nullptr, (bf16_t*)(ws + WS_WD), FF, DM, DM, scr, r, lane);
    }
    {
        const float invf[8] = {1.0f, 0.1939227432012558f, 0.03760603070259094f, 0.007292664609849453f, 0.0014142135623842478f, 0.00027424818836152554f, 5.318296098266728e-05f, 1.0313386155758053e-05f};
        float* rope = (float*)(ws + WS_ROPE);
        for (int idx = gw * 64 + lane; idx < SEQ * 8; idx += NGW * 64) {
            const int pos = idx >> 3, i = idx & 7;
            float fr_ = invf[0];
#pragma unroll
            for (int j = 1; j < 8; ++j) fr_ = (i == j) ? invf[j] : fr_;
            const float angf = (float)pos * fr_;
            const double a = (double)angf, kq = rint(a * 0.63661977236758134308);
            double r = fma(-kq, 1.5707963267948966, a); r = fma(-kq, 6.123233995736766e-17, r);
            const int q = (int)((long long)kq & 3);
            const double r2 = r * r;
            const double sr = r * (1.0 + r2 * (-1.0 / 6 + r2 * (1.0 / 120 + r2 * (-1.0 / 5040 + r2 * (1.0 / 362880 + r2 * (-1.0 / 39916800 + r2 * (1.0 / 6227020800.0)))))));
            const double cr = 1.0 + r2 * (-0.5 + r2 * (1.0 / 24 + r2 * (-1.0 / 720 + r2 * (1.0 / 40320 + r2 * (-1.0 / 3628800 + r2 * (1.0 / 479001600.0))))));
            const double s = (q == 0) ? sr : (q == 1) ? cr : (q == 2) ? -sr : -cr;
            const double c = (q == 0) ? cr : (q == 1) ? -sr : (q == 2) ? -cr : sr;
            rope[idx * 2] = (float)c; rope[idx * 2 + 1] = (float)s;
        }
    }
    if (gw == 0) { float* gt = (float*)(ws + WS_GTAB);
        gt[lane] = A.g_q_fox[lane]; gt[64 + lane] = A.g_k_fox[lane]; gt[128 + lane] = 1.f; gt[192 + lane] = A.g_q_dil[lane]; gt[256 + lane] = A.g_k_dil[lane]; gt[320 + lane] = 1.f; }
    f32x4 gm[4]; f32x4 wf[4][4][2];
#pragma unroll
    for (int j = 0; j < 4; ++j) { gm[j] = *(const f32x4*)(A.g_mix + 256 * j + 4 * lane);
#pragma unroll
        for (int e = 0; e < 4; ++e) { const float* wp = A.w_in + (size_t)(256 * j + 4 * lane + e) * INC + 1536; wf[j][e][0] = *(const f32x4*)wp * gm[j][e]; wf[j][e][1] = *(const f32x4*)(wp + 4) * gm[j][e]; } }
    const int hmine = ((lane >> 5) & 1) * 4 + ((lane >> 4) & 1) * 2 + ((lane >> 3) & 1);
    const float bfg = A.b_forget[hmine];
    bf16_t* XN = (bf16_t*)(ws + WS_XN); float* logf_ = (float*)(ws + WS_LOGF);
#define P0_LOAD(V, M_) do { _Pragma("unroll") for (int j = 0; j < 4; ++j) V[j] = __builtin_nontemporal_load((const f32x4*)(A.x + (size_t)(M_) * DM) + lane + 64 * j); } while (0)
#define P0_ROW(V, M_) do { \
        f32x4 v[4]; float ss = 0.f; \
        _Pragma("unroll") for (int j = 0; j < 4; ++j) v[j] = V[j]; \
        if ((M_) + 2 * NGW < MTOK) P0_LOAD(V, (M_) + 2 * NGW); \
        _Pragma("unroll") for (int j = 0; j < 4; ++j) ss += (v[j][0] * v[j][0] + v[j][1] * v[j][1]) + (v[j][2] * v[j][2] + v[j][3] * v[j][3]); \
        const float rstd = 1.f / sqrtf(wave_sum(ss) * (1.f / DM) + EPS); \
        unsigned long long* o8 = (unsigned long long*)(XN + (size_t)(M_) * DM) + lane; \
        f32x4 f0 = {0.f, 0.f, 0.f, 0.f}, f1 = {0.f, 0.f, 0.f, 0.f}; \
        _Pragma("unroll") for (int j = 0; j < 4; ++j) { \
            const f32x4 hn = v[j] * rstd * gm[j]; \
            o8[64 * j] = (unsigned long long)cvt_pk_bf16(hn[0], hn[1]) | ((unsigned long long)cvt_pk_bf16(hn[2], hn[3]) << 32); \
            _Pragma("unroll") for (int e = 0; e < 4; ++e) { f0 += wf[j][e][0] * v[j][e]; f1 += wf[j][e][1] * v[j][e]; } } \
        f32x4 k4; \
        _Pragma("unroll") for (int e = 0; e < 4; ++e) { const float send = b5 ? f0[e] : f1[e], keep = b5 ? f1[e] : f0[e]; k4[e] = keep + __shfl_xor(send, 32); } \
        float k2[2]; \
        _Pragma("unroll") for (int e = 0; e < 2; ++e) { const float send = b4 ? k4[e] : k4[2 + e], keep = b4 ? k4[2 + e] : k4[e]; k2[e] = keep + __shfl_xor(send, 16); } \
        float k1; \
        { const float send = b3 ? k2[0] : k2[1], keep = b3 ? k2[1] : k2[0]; k1 = keep + __shfl_xor(send, 8); } \
        k1 += __shfl_xor(k1, 4); k1 += __shfl_xor(k1, 2); k1 += __shfl_xor(k1, 1); \
        const float z = k1 * rstd + bfg; \
        const float lf = (z >= 0.f) ? -log1pf(__expf(-z)) : z - log1pf(__expf(z)); \
        if ((lane & 7) == 0) logf_[(size_t)(M_) * 8 + hmine] = lf; } while (0)
    const bool b5 = (lane & 32) != 0, b4 = (lane & 16) != 0, b3 = (lane & 8) != 0;
    f32x4 va[4], vb[4];
    if (gw < MTOK) P0_LOAD(va, gw);
    if (gw + NGW < MTOK) P0_LOAD(vb, gw + NGW);
    for (int m = gw; m < MTOK; m += 2 * NGW) {
        P0_ROW(va, m);
        if (m + NGW < MTOK) P0_ROW(vb, m + NGW);
    }
#undef P0_ROW
#undef P0_LOAD
}
__device__ __forceinline__ void cumsum_phase(const Args& A, int vcu, int G, int wave, int lane) {
    if (wave != 0) return;
    const float* logf_ = (const float*)(A.ws + WS_LOGF); float* c2 = (float*)(A.ws + WS_C2);
    for (int seq = vcu; seq < BATCH * 8; seq += G) {
        const int b = seq >> 3, hh = seq & 7;
        float vals[32]; float run = 0.f;
#pragma unroll
        for (int i = 0; i < 32; ++i) { run += logf_[((size_t)b * SEQ + 32 * lane + i) * 8 + hh]; vals[i] = run; }
        float inc = run;
#pragma unroll
        for (int o = 1; o < 64; o <<= 1) { const float t = __shfl_up(inc, o); if (lane >= o) inc += t; }
        const float excl = inc - run;
#pragma unroll
        for (int i = 0; i < 32; ++i) c2[(size_t)seq * SEQ + 32 * lane + i] = (excl + vals[i]) * LOG2E;
    }
}
__device__ __forceinline__ void merge_phase(const Args& A, int vcu, int G, int wave, int lane) {
    const bf16_t* OF = (const bf16_t*)(A.ws + WS_OF); const bf16_t* OD = (const bf16_t*)(A.ws + WS_OD); const float* LSE = (const float*)(A.ws + WS_LSE); bf16_t* ON = (bf16_t*)(A.ws + WS_ON);
    const int gw = vcu * NWAVES + wave, NGW = G * NWAVES;
    float gf[8], gd[8];
    { const f32x4 a = *(const f32x4*)(A.g_out_fox + 8 * lane), b = *(const f32x4*)(A.g_out_fox + 8 * lane + 4), c = *(const f32x4*)(A.g_out_dil + 8 * lane), d = *(const f32x4*)(A.g_out_dil + 8 * lane + 4);
#pragma unroll
      for (int e = 0; e < 4; ++e) { gf[e] = a[e]; gf[4 + e] = b[e]; gd[e] = c[e]; gd[4 + e] = d[e]; } }
    u32x4 fwn, dwn[3]; float lsn[3];
#define MERGE_LOAD(M_) do { fwn = __builtin_nontemporal_load((const u32x4*)(OF + (size_t)(M_) * 512 + 8 * lane)); \
        _Pragma("unroll") for (int i = 0; i < 3; ++i) { dwn[i] = __builtin_nontemporal_load((const u32x4*)(OD + (size_t)i * OD_STRIDE + (size_t)(M_) * 512 + 8 * lane)); lsn[i] = LSE[((size_t)i * MTOK + (M_)) * 8 + (lane >> 3)]; } } while (0)
    if (gw < MTOK) MERGE_LOAD(gw);
    for (int m = gw; m < MTOK; m += NGW) {
        const u32x4 fw = fwn; u32x4 dwc[3]; float ls[3];
#pragma unroll
        for (int i = 0; i < 3; ++i) { dwc[i] = dwn[i]; ls[i] = lsn[i]; }
        if (m + NGW < MTOK) MERGE_LOAD(m + NGW);
        float of[8], od[8] = {0.f, 0.f, 0.f, 0.f, 0.f, 0.f, 0.f, 0.f};
#pragma unroll
        for (int e = 0; e < 4; ++e) { of[2 * e] = __uint_as_float(fw[e] << 16); of[2 * e + 1] = __uint_as_float(fw[e] & 0xffff0000u); }
        const float mx = fmaxf(ls[0], fmaxf(ls[1], ls[2]));
        float wsum = 0.f;
#pragma unroll
        for (int i = 0; i < 3; ++i) {
            const float w = __builtin_amdgcn_exp2f(ls[i] - mx); wsum += w;
            const u32x4 dw = dwc[i];
#pragma unroll
            for (int e = 0; e < 4; ++e) { od[2 * e] += w * __uint_as_float(dw[e] << 16); od[2 * e + 1] += w * __uint_as_float(dw[e] & 0xffff0000u); }
        }
        const float iw = 1.f / wsum; float sf = 0.f, sd = 0.f;
#pragma unroll
        for (int e = 0; e < 8; ++e) { od[e] *= iw; sf += of[e] * of[e]; sd += od[e] * od[e]; }
        const float rf = 1.f / sqrtf(wave_sum(sf) * (1.f / 512.f) + EPS), rd = 1.f / sqrtf(wave_sum(sd) * (1.f / 512.f) + EPS);
        u32x4 a, b;
        a.x = cvt_pk_bf16(of[0] * rf * gf[0], of[1] * rf * gf[1]); a.y = cvt_pk_bf16(of[2] * rf * gf[2], of[3] * rf * gf[3]); a.z = cvt_pk_bf16(of[4] * rf * gf[4], of[5] * rf * gf[5]); a.w = cvt_pk_bf16(of[6] * rf * gf[6], of[7] * rf * gf[7]);
        b.x = cvt_pk_bf16(od[0] * rd * gd[0], od[1] * rd * gd[1]); b.y = cvt_pk_bf16(od[2] * rd * gd[2], od[3] * rd * gd[3]); b.z = cvt_pk_bf16(od[4] * rd * gd[4], od[5] * rd * gd[5]); b.w = cvt_pk_bf16(od[6] * rd * gd[6], od[7] * rd * gd[7]);
        *(u32x4*)(ON + (size_t)m * DM + 8 * lane) = a;
        *(u32x4*)(ON + (size_t)m * DM + 512 + 8 * lane) = b;
    }
}

namespace att {
typedef short bf16x8 __attribute__((ext_vector_type(8)));
typedef short s16x4 __attribute__((ext_vector_type(4)));
typedef float f32x16 __attribute__((ext_vector_type(16)));
typedef float f32x2_t __attribute__((ext_vector_type(2)));
typedef __bf16 bf16x2_t __attribute__((ext_vector_type(2)));
constexpr int KP = 144, TILE_B = 64 * KP, BUF_B = 2 * TILE_B + 256, DIL_V = 384 * KP;
constexpr float NEGBIG = -1e30f;
constexpr int NUNITS = 36 * 256;
__device__ __forceinline__ unsigned cvtpk(float lo, float hi) { f32x2_t v = {lo, hi}; bf16x2_t b = __builtin_convertvector(v, bf16x2_t); return __builtin_bit_cast(unsigned, b); }
__device__ __forceinline__ s16x4 vtr(const LAS unsigned char* p) { return __builtin_bit_cast(s16x4, __builtin_amdgcn_ds_read_tr16_b64_v4i16((LAS s16x4*)p)); }
#define ATT_MFMA(a, b, c) __builtin_amdgcn_mfma_f32_32x32x16_bf16((a), (b), (c), 0, 0, 0)

__device__ __forceinline__ void mask_blk(f32x16& s0, f32x16& s1, int bs, int W) {
#pragma unroll
    for (int i = 0; i < 16; ++i) { const int off = (i & 3) + 8 * (i >> 2);
        if ((unsigned)(bs - off) > (unsigned)W) s0[i] = NEGBIG;
        if ((unsigned)(bs - 32 - off) > (unsigned)W) s1[i] = NEGBIG; }
}
__device__ __forceinline__ void softmax_blk(f32x16& t0, f32x16& t1, float& m, float& l, f32x16& o0, f32x16& o1, u32x4 (&pw)[4]) {
    int im = max(__float_as_int(t0[0]), __float_as_int(t1[0]));
#pragma unroll
    for (int i = 1; i < 16; ++i) im = max(im, max(__float_as_int(t0[i]), __float_as_int(t1[i])));
    { auto rr = __builtin_amdgcn_permlane32_swap((unsigned)im, (unsigned)im, false, false); im = max((int)rr[0], (int)rr[1]); }
    if (__builtin_amdgcn_ballot_w64(im > 0x41000000) != 0ull) {
        float mx = fmaxf(t0[0], t1[0]);
#pragma unroll
        for (int i = 1; i < 16; ++i) mx = fmaxf(mx, fmaxf(t0[i], t1[i]));
        { auto rr = __builtin_amdgcn_permlane32_swap(__float_as_uint(mx), __float_as_uint(mx), false, false); mx = fmaxf(__uint_as_float(rr[0]), __uint_as_float(rr[1])); }
        const float dl = fmaxf(mx, 0.f), al = __builtin_amdgcn_exp2f(-dl);
        m += dl; l *= al;
#pragma unroll
        for (int i = 0; i < 16; ++i) { t0[i] -= dl; t1[i] -= dl; o0[i] *= al; o1[i] *= al; }
    }
    float ps = 0.f;
#pragma unroll
    for (int i = 0; i < 16; ++i) { t0[i] = __builtin_amdgcn_exp2f(t0[i]); t1[i] = __builtin_amdgcn_exp2f(t1[i]); ps += t0[i] + t1[i]; }
    l += ps;
#pragma unroll
    for (int sp = 0; sp < 2; ++sp) {
        pw[sp].x = cvtpk(t0[8 * sp], t0[8 * sp + 1]); pw[sp].y = cvtpk(t0[8 * sp + 2], t0[8 * sp + 3]); pw[sp].z = cvtpk(t0[8 * sp + 4], t0[8 * sp + 5]); pw[sp].w = cvtpk(t0[8 * sp + 6], t0[8 * sp + 7]);
        pw[2 + sp].x = cvtpk(t1[8 * sp], t1[8 * sp + 1]); pw[2 + sp].y = cvtpk(t1[8 * sp + 2], t1[8 * sp + 3]); pw[2 + sp].z = cvtpk(t1[8 * sp + 4], t1[8 * sp + 5]); pw[2 + sp].w = cvtpk(t1[8 * sp + 6], t1[8 * sp + 7]);
    }
}
__device__ __forceinline__ void store_blk(const f32x16& o0, const f32x16& o1, float m, float l, bf16_t* op, int rstride, float* lp, LAS unsigned char* stg, int lane) {
    const int r32 = lane & 31, h = lane >> 5;
    float lt = l;
    { auto rr = __builtin_amdgcn_permlane32_swap(__float_as_uint(l), __float_as_uint(l), false, false); lt = __uint_as_float(rr[0]) + __uint_as_float(rr[1]); }
    const float il = 1.f / lt;
    LAS unsigned char* wp = stg + r32 * 136 + 8 * h;
#pragma unroll
    for (int g = 0; g < 4; ++g) {
        u32x2 w0, w1;
        w0.x = cvtpk(o0[4 * g] * il, o0[4 * g + 1] * il); w0.y = cvtpk(o0[4 * g + 2] * il, o0[4 * g + 3] * il);
        w1.x = cvtpk(o1[4 * g] * il, o1[4 * g + 1] * il); w1.y = cvtpk(o1[4 * g + 2] * il, o1[4 * g + 3] * il);
        *(LAS u32x2*)(wp + 16 * g) = w0; *(LAS u32x2*)(wp + 64 + 16 * g) = w1;
    }
    const int ch = lane & 7;
#pragma unroll
    for (int ps = 0; ps < 4; ++ps) {
        const int rw = ps * 8 + (lane >> 3);
        const LAS unsigned char* rp = stg + rw * 136 + ch * 16;
        const u32x2 a = *(const LAS u32x2*)rp, b = *(const LAS u32x2*)(rp + 8);
        u32x4 v; v.x = a.x; v.y = a.y; v.z = b.x; v.w = b.y;
        *(u32x4*)(op + (long)(rw - r32) * rstride + ch * 8) = v;
    }
    if (lp && h == 0) *lp = m + __builtin_amdgcn_logf(lt);
}

__device__ __forceinline__ void fox_unit(LAS unsigned char* lds, const bf16_t* __restrict__ QKV, const float* __restrict__ c2, bf16_t* __restrict__ Oout, int bh, int p0, int tid, int lane, int wave) {
    const int b = bh >> 3, hh = bh & 7, r32 = lane & 31, h = lane >> 5;
    const bf16_t* base = QKV + (size_t)bh * HSTRIDE;
    const float* cc = c2 + (size_t)bh * SEQ;
    const int wqA = p0 + 32 * wave, wqB = p0 + 32 * (15 - wave), tA = wqA >> 6, tB = wqB >> 6;
    bf16x8 qfA[4], qfB[4];
#pragma unroll
    for (int ks = 0; ks < 4; ++ks) { qfA[ks] = *(const bf16x8*)(base + (size_t)(wqA + r32) * 64 + 16 * ks + 8 * h); qfB[ks] = *(const bf16x8*)(base + (size_t)(wqB + r32) * 64 + 16 * ks + 8 * h); }
    const float cqA = cc[wqA + r32], cqB = cc[wqB + r32];
    const int n_st = (p0 + 512) >> 7;
    const int skey = tid >> 3, sch = tid & 7;
    const bf16_t* gk = base + SECS + (size_t)skey * 64 + sch * 8;
    const size_t tstep = (size_t)64 * 64;
    const int soff = skey * KP + sch * 16, coff = (tid >> 6) * BUF_B + 2 * TILE_B + (tid & 63) * 4;
    u32x4 kreg0 = *(const u32x4*)gk, vreg0 = *(const u32x4*)(gk + SECS), kreg1 = *(const u32x4*)(gk + tstep), vreg1 = *(const u32x4*)(gk + tstep + SECS); float creg = 0.f;
    if (tid < 128) creg = cc[tid];
    *(LAS u32x4*)(lds + soff) = kreg0; *(LAS u32x4*)(lds + TILE_B + soff) = vreg0; *(LAS u32x4*)(lds + BUF_B + soff) = kreg1; *(LAS u32x4*)(lds + BUF_B + TILE_B + soff) = vreg1;
    if (tid < 128) *(LAS float*)(lds + coff) = creg;
    __syncthreads();
    float mA = 0.f, lA = 0.f, mB = 0.f, lB = 0.f; f32x16 oA0, oA1, oB0, oB1;
#pragma unroll
    for (int i = 0; i < 16; ++i) { oA0[i] = 0.f; oA1[i] = 0.f; oB0[i] = 0.f; oB1[i] = 0.f; }
    const int i16 = lane & 15, vq = i16 >> 2, vp = i16 & 3, vblk = (lane >> 4) & 1;
    const int voff = (4 * h + vq) * KP + (16 * vblk + 4 * vp) * 2;
    for (int st = 0; st < n_st; ++st) {
        const int cur = st & 1; const bool more = st + 1 < n_st;
        if (more) { const bf16_t* gn = gk + (size_t)(2 * st + 2) * tstep; kreg0 = *(const u32x4*)gn; vreg0 = *(const u32x4*)(gn + SECS); kreg1 = *(const u32x4*)(gn + tstep); vreg1 = *(const u32x4*)(gn + tstep + SECS);
                    if (tid < 128) creg = cc[(st + 1) * 128 + tid]; }
#pragma unroll 1
        for (int sub = 0; sub < 2; ++sub) {
        const int tk0 = st * 128 + sub * 64, tix = 2 * st + sub;
        if (tix <= tB) {
            const bool doA = tix <= tA;
            const LAS unsigned char* kb_ = lds + (cur * 2 + sub) * BUF_B; const LAS unsigned char* vb_ = kb_ + TILE_B; const LAS float* cb_ = (const LAS float*)(kb_ + 2 * TILE_B);
            f32x16 sA0, sA1, sB0, sB1;
            { const float cmA = cqA - mA, cmB = cqB - mB;
#pragma unroll
            for (int g = 0; g < 4; ++g) { const f32x4 c0 = *(const LAS f32x4*)(cb_ + 8 * g + 4 * h), c1 = *(const LAS f32x4*)(cb_ + 32 + 8 * g + 4 * h);
#pragma unroll
                for (int e = 0; e < 4; ++e) { sA0[4 * g + e] = cmA - c0[e]; sA1[4 * g + e] = cmA - c1[e]; sB0[4 * g + e] = cmB - c0[e]; sB1[4 * g + e] = cmB - c1[e]; } } }
#pragma unroll
            for (int kh = 0; kh < 2; ++kh) { bf16x8 kf[4];
#pragma unroll
                for (int k2 = 0; k2 < 2; ++k2) { const int ks = 2 * kh + k2; kf[2 * k2] = *(const LAS bf16x8*)(kb_ + r32 * KP + (16 * ks + 8 * h) * 2); kf[2 * k2 + 1] = *(const LAS bf16x8*)(kb_ + (32 + r32) * KP + (16 * ks + 8 * h) * 2); }
                __builtin_amdgcn_sched_barrier(0);
#pragma unroll
                for (int k2 = 0; k2 < 2; ++k2) { const int ks = 2 * kh + k2; sB0 = ATT_MFMA(kf[2 * k2], qfB[ks], sB0); sB1 = ATT_MFMA(kf[2 * k2 + 1], qfB[ks], sB1); }
                if (doA) {
#pragma unroll
                    for (int k2 = 0; k2 < 2; ++k2) { const int ks = 2 * kh + k2; sA0 = ATT_MFMA(kf[2 * k2], qfA[ks], sA0); sA1 = ATT_MFMA(kf[2 * k2 + 1], qfA[ks], sA1); }
                }
            }
            if (tix == tB) mask_blk(sB0, sB1, wqB + r32 - tk0 - 4 * h, 4096);
            u32x4 pA[4], pB[4];
            if (doA) {
                if (tix == tA) mask_blk(sA0, sA1, wqA + r32 - tk0 - 4 * h, 4096);
                softmax_blk(sA0, sA1, mA, lA, oA0, oA1, pA);
            }
            softmax_blk(sB0, sB1, mB, lB, oB0, oB1, pB);
#pragma unroll
            for (int idx = 0; idx < 4; ++idx) {
                const LAS unsigned char* vp_ = vb_ + (16 * idx) * KP + voff;
                const s16x4 a0 = vtr(vp_), a1 = vtr(vp_ + 8 * KP), b0 = vtr(vp_ + 64), b1 = vtr(vp_ + 8 * KP + 64);
                const bf16x8 vf0 = __builtin_shufflevector(a0, a1, 0, 1, 2, 3, 4, 5, 6, 7), vf1 = __builtin_shufflevector(b0, b1, 0, 1, 2, 3, 4, 5, 6, 7);
                const bf16x8 pfB = __builtin_bit_cast(bf16x8, pB[idx]);
                oB0 = ATT_MFMA(vf0, pfB, oB0); oB1 = ATT_MFMA(vf1, pfB, oB1);
                if (doA) { const bf16x8 pfA = __builtin_bit_cast(bf16x8, pA[idx]); oA0 = ATT_MFMA(vf0, pfA, oA0); oA1 = ATT_MFMA(vf1, pfA, oA1); }
            }
        }
        }
        if (more) { const int nb = (cur ^ 1) * 2 * BUF_B; *(LAS u32x4*)(lds + nb + soff) = kreg0; *(LAS u32x4*)(lds + nb + TILE_B + soff) = vreg0; *(LAS u32x4*)(lds + nb + BUF_B + soff) = kreg1; *(LAS u32x4*)(lds + nb + BUF_B + TILE_B + soff) = vreg1;
                    if (tid < 128) *(LAS float*)(lds + nb + coff) = creg; }
        __syncthreads();
    }
    LAS unsigned char* stg = lds + (wave < 4 ? 110592 + wave * 4352 : 131072 + 256 + 4096 + 256 + (wave - 4) * 4352);
    store_blk(oA0, oA1, mA, lA, Oout + ((size_t)b * SEQ + wqA + r32) * 512 + hh * 64, 512, nullptr, stg, lane);
    store_blk(oB0, oB1, mB, lB, Oout + ((size_t)b * SEQ + wqB + r32) * 512 + hh * 64, 512, nullptr, stg, lane);
}
struct DilDesc { int bh, br, dd, p0, klo, nkt, rr0; };
__device__ __forceinline__ DilDesc dil_desc(int k, int vcu, int G) {
    DilDesc d; int i;
    if (G == 256) { const int xcd = vcu >> 5, c = vcu & 31, g = k / 3, sub = k - 3 * g; d.bh = 32 * xcd + 4 * g + (c >> 3); i = (c & 7) + 8 * sub; }
    else { const int u = vcu + k * G; d.bh = u & 255; i = u >> 8; }
    if (i < 8) { d.br = 0; d.dd = 1; d.p0 = 256 * i; d.rr0 = 0; }
    else if (i < 16) { d.br = 1; d.dd = 4; d.p0 = 256 * ((i - 8) & 1); d.rr0 = (i - 8) >> 1; }
    else { d.br = 2; d.dd = 16; d.p0 = 0; d.rr0 = 2 * (i - 16); }
    d.klo = d.p0 >= 128 ? d.p0 - 128 : 0; d.nkt = d.br == 2 ? 4 : (d.p0 + 256 - d.klo) >> 6;
    return d;
}
__device__ __forceinline__ void dil_compute(const LAS unsigned char* lds, const DilDesc& c, const bf16x8 (&qf)[4], int wave, int r32, int h, int voff, f32x16& o0, f32x16& o1, float& m, float& l, size_t& qrow) {
    const int seg = c.br == 2 ? (wave >> 2) : 0, wq0 = c.br == 2 ? 32 * (wave & 3) : c.p0 + 32 * wave, rr = c.rr0 + seg, klo = c.br == 2 ? 0 : c.klo;
    const LAS unsigned char* segb = lds + seg * 2 * TILE_B;
    m = 0.f; l = 0.f;
#pragma unroll
    for (int i = 0; i < 16; ++i) { o0[i] = 0.f; o1[i] = 0.f; }
    const int t_lo = (wq0 >= 128 ? wq0 - 128 : 0) >> 6, t_hi = wq0 >> 6;
    for (int t = t_lo; t <= t_hi; ++t) {
        const int tk0 = t * 64;
        const LAS unsigned char* kb_ = segb + (tk0 - klo) * KP; const LAS unsigned char* vb_ = kb_ + DIL_V;
        f32x16 s0, s1;
#pragma unroll
        for (int i = 0; i < 16; ++i) { s0[i] = -m; s1[i] = -m; }
#pragma unroll
        for (int kh = 0; kh < 2; ++kh) { bf16x8 kf[4];
#pragma unroll
            for (int k2 = 0; k2 < 2; ++k2) { const int ks = 2 * kh + k2; kf[2 * k2] = *(const LAS bf16x8*)(kb_ + r32 * KP + (16 * ks + 8 * h) * 2); kf[2 * k2 + 1] = *(const LAS bf16x8*)(kb_ + (32 + r32) * KP + (16 * ks + 8 * h) * 2); }
            __builtin_amdgcn_sched_barrier(0);
#pragma unroll
            for (int k2 = 0; k2 < 2; ++k2) { const int ks = 2 * kh + k2; s0 = ATT_MFMA(kf[2 * k2], qf[ks], s0); s1 = ATT_MFMA(kf[2 * k2 + 1], qf[ks], s1); }
        }
        if (tk0 + 63 > wq0 || wq0 + 31 - tk0 > 128) mask_blk(s0, s1, wq0 + r32 - tk0 - 4 * h, 128);
        u32x4 pw[4];
        softmax_blk(s0, s1, m, l, o0, o1, pw);
#pragma unroll
        for (int idx = 0; idx < 4; ++idx) {
            const LAS unsigned char* vp_ = vb_ + (16 * idx) * KP + voff;
            const s16x4 a0 = vtr(vp_), a1 = vtr(vp_ + 8 * KP), b0 = vtr(vp_ + 64), b1 = vtr(vp_ + 8 * KP + 64);
            const bf16x8 vf0 = __builtin_shufflevector(a0, a1, 0, 1, 2, 3, 4, 5, 6, 7), vf1 = __builtin_shufflevector(b0, b1, 0, 1, 2, 3, 4, 5, 6, 7);
            const bf16x8 pf = __builtin_bit_cast(bf16x8, pw[idx]);
            o0 = ATT_MFMA(vf0, pf, o0); o1 = ATT_MFMA(vf1, pf, o1);
        }
    }
    qrow = (size_t)(c.bh >> 3) * SEQ + (size_t)(wq0 + r32) * c.dd + rr;
}
__device__ __forceinline__ void dil_phase(LAS unsigned char* lds, const bf16_t* __restrict__ QKV, bf16_t* __restrict__ OD, float* __restrict__ LSE, int vcu, int G, int tid, int lane, int wave) {
    const int r32 = lane & 31, h = lane >> 5, skey = tid >> 3, sch = tid & 7, soff = skey * KP + sch * 16;
    const int i16 = lane & 15, vq = i16 >> 2, vp = i16 & 3, vblk = (lane >> 4) & 1;
    const int voff = (4 * h + vq) * KP + (16 * vblk + 4 * vp) * 2;
    const int nsteps = (G == 256) ? 24 : (24 * 256 - vcu + G - 1) / G;
    if (nsteps <= 0) return;
    u32x4 krA[6], vrA[6], krB[6], vrB[6]; bf16x8 qn[4];
    DilDesc dA = dil_desc(0, vcu, G), dB = dA;
#define DIL_ISSUE(D, KR, VR) do { \
        const bf16_t* base_ = QKV + (size_t)(3 * 256 + (D).bh) * HSTRIDE; \
        _Pragma("unroll") for (int j = 0; j < 6; ++j) if (j < (D).nkt) { \
            const int kpos_ = (D).br == 2 ? 64 * (j & 1) : (D).klo + 64 * j, rr_ = (D).br == 2 ? (D).rr0 + (j >> 1) : (D).rr0; \
            const bf16_t* g_ = base_ + SECS + (size_t)((kpos_ + skey) * (D).dd + rr_) * 64 + sch * 8; \
            KR[j] = *(const u32x4*)g_; VR[j] = *(const u32x4*)(g_ + SECS); } } while (0)
#define DIL_ISSUE_Q(D) do { \
        const bf16_t* base_ = QKV + (size_t)(3 * 256 + (D).bh) * HSTRIDE; \
        const int seg_ = (D).br == 2 ? (wave >> 2) : 0, wq_ = (D).br == 2 ? 32 * (wave & 3) : (D).p0 + 32 * wave; \
        const bf16_t* q_ = base_ + (size_t)((wq_ + r32) * (D).dd + (D).rr0 + seg_) * 64 + 8 * h; \
        _Pragma("unroll") for (int ks = 0; ks < 4; ++ks) qn[ks] = *(const bf16x8*)(q_ + 16 * ks); } while (0)
    DIL_ISSUE(dA, krA, vrA); DIL_ISSUE_Q(dA);
    if (nsteps > 1) { dB = dil_desc(1, vcu, G); DIL_ISSUE(dB, krB, vrB); }
    bool pend = false; f32x16 po0, po1; float pm = 0.f, pl = 1.f; bf16_t* pop = OD; float* plp = LSE; int prs = 512;
    LAS unsigned char* stg = lds + (wave < 4 ? 110592 + wave * 4352 : 131072 + 256 + 4096 + 256 + (wave - 4) * 4352);
#pragma unroll
    for (int i = 0; i < 16; ++i) { po0[i] = 0.f; po1[i] = 0.f; }
#define DIL_STEP(D, DOTHER, KR, VR, KIDX) do { \
        _Pragma("unroll") for (int j = 0; j < 6; ++j) if (j < (D).nkt) { *(LAS u32x4*)(lds + j * TILE_B + soff) = KR[j]; *(LAS u32x4*)(lds + DIL_V + j * TILE_B + soff) = VR[j]; } \
        bf16x8 qf[4]; \
        _Pragma("unroll") for (int ks = 0; ks < 4; ++ks) qf[ks] = qn[ks]; \
        asm volatile("s_waitcnt lgkmcnt(0)\n\ts_barrier" ::: "memory"); \
        const DilDesc c = (D); \
        if ((KIDX) + 2 < nsteps) { (D) = dil_desc((KIDX) + 2, vcu, G); DIL_ISSUE((D), KR, VR); } \
        if ((KIDX) + 1 < nsteps) DIL_ISSUE_Q(DOTHER); \
        if (pend) store_blk(po0, po1, pm, pl, pop, prs, plp, stg, lane); \
        size_t qrow; \
        dil_compute(lds, c, qf, wave, r32, h, voff, po0, po1, pm, pl, qrow); pend = true; \
        pop = OD + (size_t)c.br * OD_STRIDE + qrow * 512 + (c.bh & 7) * 64; plp = LSE + (size_t)c.br * MTOK * 8 + qrow * 8 + (c.bh & 7); prs = c.dd * 512; \
        asm volatile("s_waitcnt lgkmcnt(0)\n\ts_barrier" ::: "memory"); } while (0)
    for (int k = 0; k < nsteps; k += 2) {
        DIL_STEP(dA, dB, krA, vrA, k);
        if (k + 1 >= nsteps) break;
        DIL_STEP(dB, dA, krB, vrB, k + 1);
    }
    if (pend) store_blk(po0, po1, pm, pl, pop, prs, plp, stg, lane);
#undef DIL_STEP
#undef DIL_ISSUE_Q
#undef DIL_ISSUE
}
__device__ __forceinline__ void attn_phase(LAS unsigned char* lds, unsigned char* ws, int vcu, int G, int tid, int lane, int wave) {
    const bf16_t* QKV = (const bf16_t*)(ws + WS_QKV); const float* c2 = (const float*)(ws + WS_C2);
    bf16_t* OF = (bf16_t*)(ws + WS_OF); bf16_t* OD = (bf16_t*)(ws + WS_OD); float* LSE = (float*)(ws + WS_LSE);
    for (int u = vcu; u < 4 * 256; u += G) fox_unit(lds, QKV, c2, OF, u & 255, (3 - (u >> 8)) * 512, tid, lane, wave);
    dil_phase(lds, QKV, OD, LSE, vcu, G, tid, lane, wave);
}
}

#define RLX_AGENT __ATOMIC_RELAXED, __HIP_MEMORY_SCOPE_AGENT
#define XB_TMO      128
#define XB_XCNT(j)  (256  + 64 * (j))
#define XB_XSUB(j)  (1280 + 64 * (j))
#define XB_XGEN(j)  (2304 + 64 * (j))
#define XB_TOP      3328
#define XB_TOPGEN   3392
#define XCD_BAR_WORDS 3456
#define XB_SPIN_CAP (1u << 18)

__device__ __forceinline__ unsigned xb_ld(unsigned* p)              { return __hip_atomic_load(p, __ATOMIC_RELAXED, __HIP_MEMORY_SCOPE_AGENT); }
__device__ __forceinline__ unsigned xb_add(unsigned* p, unsigned v) { return __hip_atomic_fetch_add(p, v, __ATOMIC_RELAXED, __HIP_MEMORY_SCOPE_AGENT); }
__device__ __forceinline__ unsigned xb_xcc_id() { return (unsigned)__builtin_amdgcn_s_getreg((3 << 11) | 20) & 0xFu; }
#define XB_SPIN(cond, bar) do { unsigned _sp = 0; while (cond) { __builtin_amdgcn_s_sleep(1); \
    if ((++_sp & 255u) == 0u) { if (xb_ld(&(bar)[XB_TMO])) break; if (_sp > XB_SPIN_CAP) { atomicAdd(&(bar)[XB_TMO], 1u); break; } } } } while (0)

struct XcdBarrier {
    unsigned* bar; unsigned x;
    volatile LAS unsigned* st;
};

__device__ __forceinline__ XcdBarrier xcd_barrier_post(unsigned* bar, volatile LAS unsigned* st) {
    XcdBarrier b; b.bar = bar; b.x = xb_xcc_id(); b.st = st;
    if (threadIdx.x == 0) (void)xb_add(&bar[XB_XCNT(b.x)], 1u);
    return b;
}
__device__ __forceinline__ void xcd_barrier_complete(unsigned* bar, unsigned x, unsigned& nloc, unsigned& nx) {
    const unsigned G = gridDim.x * gridDim.y * gridDim.z;
    unsigned sum, cnt, mine, sp = 0u;
    for (;;) {
        sum = 0u; cnt = 0u; mine = 0u;
#pragma unroll
        for (unsigned j = 0; j < 16; ++j) { const unsigned c = xb_ld(&bar[XB_XCNT(j)]); sum += c; cnt += (c > 0u) ? 1u : 0u; mine = (j == x) ? c : mine; }
        if (sum == G) break;
        __builtin_amdgcn_s_sleep(1);
        if ((++sp & 255u) == 0u) { if (xb_ld(&bar[XB_TMO])) break; if (sp > XB_SPIN_CAP) { atomicAdd(&bar[XB_TMO], 1u); break; } }
    }
    nloc = mine > 0u ? mine : 1u; nx = cnt > 0u ? cnt : 1u;
}

__device__ __forceinline__ void xcd_barrier(const XcdBarrier& b) {
    asm volatile("s_waitcnt vmcnt(0)" ::: "memory");
    __syncthreads();
    if (threadIdx.x == 0) {
        unsigned* bar = b.bar;
        __builtin_amdgcn_s_waitcnt(0);
        unsigned nloc = b.st[0], nx = b.st[1];
        if (nloc == 0u) { xcd_barrier_complete(bar, b.x, nloc, nx); b.st[0] = nloc; b.st[1] = nx; }
        const unsigned old = xb_add(&bar[XB_XSUB(b.x)], 1u);
        const unsigned gen = old / nloc;
        if (old + 1u == (gen + 1u) * nloc) {
            __builtin_amdgcn_fence(__ATOMIC_RELEASE, "agent");
            asm volatile("s_waitcnt vmcnt(0)" ::: "memory");
            const unsigned og = xb_add(&bar[XB_TOP], 1u);
            const unsigned tg = og / nx;
            if (og + 1u == (tg + 1u) * nx) xb_add(&bar[XB_TOPGEN], 1u);
            else XB_SPIN(xb_ld(&bar[XB_TOPGEN]) == tg, bar);
            __builtin_amdgcn_fence(__ATOMIC_ACQUIRE, "agent");
            xb_add(&bar[XB_XGEN(b.x)], 1u);
            asm volatile("s_waitcnt vmcnt(0)" ::: "memory");
        } else {
            XB_SPIN(xb_ld(&bar[XB_XGEN(b.x)]) == gen, bar);
            __builtin_amdgcn_fence(__ATOMIC_ACQUIRE, "agent");
            asm volatile("s_waitcnt vmcnt(0)" ::: "memory");
        }
    }
    __syncthreads();
}

__global__ void __launch_bounds__(NTHREADS, 2) fwd_kernel(Args A) {
    extern __shared__ __attribute__((aligned(16))) unsigned char lds_raw[];
    LAS unsigned char* lds = (LAS unsigned char*)lds_raw;
    const int tid = threadIdx.x, lane = tid & 63, wave = __builtin_amdgcn_readfirstlane(tid >> 6);
    const int G = gridDim.x, bx = blockIdx.x, vcu = (G % 8 == 0) ? (bx % 8) * (G / 8) + bx / 8 : bx;
    unsigned char* ws = A.ws;
    const int lo = A.ph_lo, hi = A.ph_hi;
    volatile LAS unsigned* bst = (volatile LAS unsigned*)(lds + 131072);
    if (tid < 2) bst[tid] = 0u;
    __syncthreads();
    XcdBarrier bar = xcd_barrier_post((unsigned*)(ws + WS_CTL), bst);
#define IN(k) (lo <= (k) && (k) < hi)
#define SEAM(k) do { if (IN(k) && IN((k) + 1)) { xcd_barrier(bar); } } while (0)
    if (lo > 90) cg::this_grid().sync();
    if (IN(0)) { p0_prologue(A, lds, vcu, G, wave, lane); } SEAM(0);
    if (IN(1)) {
        cumsum_phase(A, vcu, G, wave, lane);
        pg8::Gemm g{(const bf16_t*)(ws + WS_XN), (const bf16_t*)(ws + WS_WQKV), MTOK, NQKV, DM}; pg8::StaticOrder S; S.init(MTOK, NQKV, G, bx);
        EpiQKV E{(bf16_t*)(ws + WS_QKV), (const float*)(ws + WS_GTAB), (const float*)(ws + WS_ROPE)};
        pg8::gemm_phase<EpiQKV, pg8::StaticOrder, true, true>(lds, g, S, E);
    } SEAM(1);
    if (IN(2)) {
        att::attn_phase(lds, ws, vcu, G, tid, lane, wave);
    } SEAM(2);
    if (IN(3)) { merge_phase(A, vcu, G, wave, lane); } SEAM(3);
    if (IN(4)) {
        pg8::Gemm g{(const bf16_t*)(ws + WS_ON), (const bf16_t*)(ws + WS_WO), MTOK, DM, DM}; pg8::StaticOrder S; S.init(MTOK, DM, G, bx);
        EpiOut E{A.x, (bf16_t*)(ws + WS_X1B), (float*)(ws + WS_SSQ)};
        pg8::gemm_phase<EpiOut, pg8::StaticOrder, true, true>(lds, g, S, E);
    } SEAM(4);
    if (IN(5)) {
        pg8::Gemm g{(const bf16_t*)(ws + WS_X1B), (const bf16_t*)(ws + WS_WGU), MTOK, NGU, DM}; pg8::StaticOrder S; S.init(MTOK, NGU, G, bx);
        EpiGU E{(bf16_t*)(ws + WS_H), (const float*)(ws + WS_SSQ), (LAS float*)(lds + 131072 + 256), -1};
        pg8::gemm_phase<EpiGU, pg8::StaticOrder, true, true>(lds, g, S, E);
    } SEAM(5);
    if (IN(6)) {
        pg8::Gemm g{(const bf16_t*)(ws + WS_H), (const bf16_t*)(ws + WS_WD), MTOK, DM, FF}; pg8::StaticOrder S; S.init(MTOK, DM, G, bx);
        EpiDown E{A.out, (const bf16_t*)(ws + WS_X1B)};
        pg8::gemm_phase<EpiDown, pg8::StaticOrder, true, true>(lds, g, S, E);
    }
#undef IN
#undef SEAM
}

extern "C" void kernel_launch(void* const* d_in, const int* in_sizes, int n_in, void* d_out, int out_size, void* d_ws, size_t ws_size, hipStream_t stream) {
    static int grid = 0;
    if (grid == 0) {
        if (n_in != 15 || out_size != MTOK * DM || ws_size < WS_END) { fprintf(stderr, "kernel_launch: unexpected shapes (n_in %d out %d ws %zu)\n", n_in, out_size, ws_size); grid = -1; return; }
        if (hipFuncSetAttribute((const void*)fwd_kernel, hipFuncAttributeMaxDynamicSharedMemorySize, LDS_BYTES) != hipSuccess) { fprintf(stderr, "kernel_launch: hipFuncSetAttribute failed\n"); grid = -1; return; }
        int dev = 0, cus = 0, per_cu = 0;
        hipGetDevice(&dev); hipDeviceGetAttribute(&cus, hipDeviceAttributeMultiprocessorCount, dev);
        hipOccupancyMaxActiveBlocksPerMultiprocessor(&per_cu, (const void*)fwd_kernel, NTHREADS, LDS_BYTES);
        (void)hipGetLastError();
        grid = (cus > 0 ? cus : 256) * (per_cu > 0 ? per_cu : 1);
        fprintf(stderr, "kernel_launch: cus %d per_cu %d grid %d\n", cus, per_cu, grid);
    }
    if (grid < 0) return;
    Args a{};
    a.x = (const float*)d_in[0]; a.g_mix = (const float*)d_in[1]; a.w_in = (const float*)d_in[2]; a.b_forget = (const float*)d_in[3]; a.g_q_fox = (const float*)d_in[4]; a.g_k_fox = (const float*)d_in[5];
    a.g_q_dil = (const float*)d_in[6]; a.g_k_dil = (const float*)d_in[7]; a.g_out_fox = (const float*)d_in[8]; a.g_out_dil = (const float*)d_in[9]; a.w_out = (const float*)d_in[10]; a.g_ffn = (const float*)d_in[11];
    a.w_gate = (const float*)d_in[12]; a.w_up = (const float*)d_in[13]; a.w_down = (const float*)d_in[14];
    a.out = (float*)d_out; a.ws = (unsigned char*)d_ws;
    a.ph_lo = 0; a.ph_hi = 7;
    if (hipMemsetAsync((unsigned char*)d_ws + WS_CTL, 0, CTL_BYTES, stream) != hipSuccess) { fprintf(stderr, "kernel_launch: memset failed\n"); return; }
    void* kargs[] = {&a};
    hipError_t e = hipLaunchCooperativeKernel((const void*)fwd_kernel, dim3(grid), dim3(NTHREADS), kargs, LDS_BYTES, stream);
    if (e != hipSuccess) fprintf(stderr, "kernel_launch: cooperative launch failed: %s (grid %d)\n", hipGetErrorString(e), grid);
}
```
